# Optimizing an MI355X kernel written in HIP

```python
import math
import jax, jax.numpy as jnp
from jax import lax
import numpy as np

D_MODEL = 2048
BATCH = 2
SEQ = 16384
DEPTH = 2

HEAD_DIM = 128
ROPE_THETA = 10000.0
NORM_EPS = 1e-6
BLOCK_Q = 128
D_FF = 1536

A_HEADS = 6
A_PATTERNS = ((128, 1), (512, 4), (2048, 16))
B_HEADS = 4
B_Q_LORA = 384
B_KV_LORA = 256
B_NOPE = 64
B_ROPE = 32
B_V = 128
D_MIX_EVEN = A_HEADS * HEAD_DIM + B_HEADS * B_V
EVEN_SPLITS = (A_HEADS * HEAD_DIM, A_HEADS * HEAD_DIM, A_HEADS * HEAD_DIM, B_Q_LORA, B_KV_LORA, B_ROPE)
IN_EVEN = sum(EVEN_SPLITS)

C_WINDOWS = (2, 4, 8, 16)
C_GROUPS = len(C_WINDOWS)
C_GROUP_DIM = 128
C_WIDTH = C_GROUPS * C_GROUP_DIM
D_HEADS = 4
D_MIX_ODD = C_WIDTH + D_HEADS * HEAD_DIM
ODD_SPLITS = (C_WIDTH, D_HEADS * HEAD_DIM, D_HEADS * HEAD_DIM, D_HEADS * HEAD_DIM)
IN_ODD = sum(ODD_SPLITS)

N_EVEN = (DEPTH + 1) // 2
N_ODD = DEPTH // 2

kernel_name = "hybrid_dilated_mla_pool_stickbreak_macaron"


def rms_norm(x, g):
    x32 = x.astype(jnp.float32)
    y = x32 * lax.rsqrt(jnp.mean(x32 * x32, axis=-1, keepdims=True) + NORM_EPS)
    return (y * g.astype(jnp.float32)).astype(x.dtype)


def rope(x, pos):
    d = x.shape[-1]
    inv = ROPE_THETA ** (-jnp.arange(0, d, 2, dtype=jnp.float32) / d)
    ang = pos.astype(jnp.float32)[:, None, :, None] * inv
    cos, sin = jnp.cos(ang), jnp.sin(ang)
    x32 = x.astype(jnp.float32)
    x1, x2 = x32[..., : d // 2], x32[..., d // 2:]
    return jnp.concatenate([x1 * cos - x2 * sin, x2 * cos + x1 * sin], axis=-1).astype(x.dtype)


def swiglu(x, w_gate, w_up, w_down):
    return (jax.nn.silu(x @ w_gate) * (x @ w_up)) @ w_down


def split_heads(t, n_heads):
    b, s, _ = t.shape
    return t.reshape(b, s, n_heads, -1).transpose(0, 2, 1, 3)


def merge_heads(t):
    b, h, s, d = t.shape
    return t.transpose(0, 2, 1, 3).reshape(b, s, h * d)


def dilated_attention(q, k, v):
    b, h, s, d = q.shape
    dt = q.dtype
    q32 = q.astype(jnp.float32) * (d ** -0.5)
    k32, v32 = k.astype(jnp.float32), v.astype(jnp.float32)
    qi = jnp.arange(BLOCK_Q)
    ki = jnp.arange(2 * BLOCK_Q)
    outs, lses = [], []
    for w, dil in A_PATTERNS:
        n_back = w // dil
        assert n_back <= BLOCK_Q
        length = s // dil
        nb = -(-length // BLOCK_Q)
        lp = nb * BLOCK_Q

        def to_phase(t):
            t = t.reshape(b, h, length, dil, d).transpose(0, 1, 3, 2, 4)
            t = jnp.pad(t, ((0, 0), (0, 0), (0, 0), (0, lp - length), (0, 0)))
            return t.reshape(b, h, dil, nb, BLOCK_Q, d)

        def band(t):
            prev = jnp.pad(t, ((0, 0), (0, 0), (0, 0), (1, 0), (0, 0), (0, 0)))[:, :, :, :-1]
            return jnp.concatenate([prev, t], axis=-2)

        qp = to_phase(q32)
        kb, vb = band(to_phase(k32)), band(to_phase(v32))
        logits = jnp.einsum('bhrnqd,bhrnkd->bhrnqk', qp, kb)
        dist = BLOCK_Q + qi[:, None] - ki[None, :]
        valid = ((dist >= 0) & (dist <= n_back))[None]
        first = (jnp.arange(nb) == 0)[:, None, None] & (ki < BLOCK_Q)[None, None, :]
        valid = valid & ~first
        logits = jnp.where(valid, logits, -jnp.inf)
        m = jnp.max(logits, axis=-1, keepdims=True)
        p = jnp.exp(logits - m)
        den = jnp.sum(p, axis=-1)
        o = jnp.einsum('bhrnqk,bhrnkd->bhrnqd', p, vb) / den[..., None]
        lse = m[..., 0] + jnp.log(den)
        o = o.reshape(b, h, dil, lp, d)[:, :, :, :length].transpose(0, 1, 3, 2, 4).reshape(b, h, s, d)
        lse = lse.reshape(b, h, dil, lp)[:, :, :, :length].transpose(0, 1, 3, 2).reshape(b, h, s)
        outs.append(o)
        lses.append(lse)
    wts = jax.nn.softmax(jnp.stack(lses, axis=0), axis=0)
    return jnp.sum(wts[..., None] * jnp.stack(outs, axis=0), axis=0).astype(dt)


def causal_softmax_attention(q, k, v):
    b, h, s, dk = q.shape
    dt = v.dtype
    q32 = q.astype(jnp.float32) * (dk ** -0.5)
    k32, v32 = k.astype(jnp.float32), v.astype(jnp.float32)
    qi = jnp.arange(BLOCK_Q)
    outs = []
    for bi in range(s // BLOCK_Q):
        s0 = bi * BLOCK_Q
        n_keys = s0 + BLOCK_Q
        logits = jnp.einsum('bhqd,bhkd->bhqk', q32[:, :, s0:n_keys], k32[:, :, :n_keys])
        mask = jnp.arange(n_keys)[None, :] <= (s0 + qi)[:, None]
        p = jax.nn.softmax(jnp.where(mask, logits, -jnp.inf), axis=-1)
        outs.append(jnp.einsum('bhqk,bhkd->bhqd', p, v32[:, :, :n_keys]))
    return jnp.concatenate(outs, axis=2).astype(dt)


def stick_breaking_attention(q, k, v):
    b, h, s, d = q.shape
    dt = v.dtype
    q32 = q.astype(jnp.float32) * (d ** -0.5)
    k32, v32 = k.astype(jnp.float32), v.astype(jnp.float32)
    qi = jnp.arange(BLOCK_Q)
    kk = jnp.arange(BLOCK_Q)
    strict_after = (kk[None, :] > kk[:, None]).astype(jnp.float32)
    outs = []
    for bi in range(s // BLOCK_Q):
        s0 = bi * BLOCK_Q
        n_keys = s0 + BLOCK_Q
        nk = bi + 1
        z = jnp.einsum('bhqd,bhkd->bhqk', q32[:, :, s0:n_keys], k32[:, :, :n_keys])
        mask = jnp.arange(n_keys)[None, :] < (s0 + qi)[:, None]
        ls_neg = jax.nn.log_sigmoid(-z)
        log_keep = jnp.where(mask, ls_neg, 0.0).reshape(b, h, BLOCK_Q, nk, BLOCK_Q)
        within = jnp.einsum('bhqnk,jk->bhqnj', log_keep, strict_after)
        totals = jnp.sum(log_keep, axis=-1)
        later_blocks = lax.cumsum(totals, axis=3, reverse=True) - totals
        after = (within + later_blocks[..., None]).reshape(b, h, BLOCK_Q, n_keys)
        a = jnp.where(mask, jnp.exp(z + ls_neg + after), 0.0)
        outs.append(jnp.einsum('bhqk,bhkd->bhqd', a, v32[:, :, :n_keys]))
    return jnp.concatenate(outs, axis=2).astype(dt)


def pool_mixer(u, w_group, scale):
    b, s, c = u.shape
    u32 = u.astype(jnp.float32)
    cs = jnp.concatenate([jnp.zeros((b, 1, c), jnp.float32), lax.cumsum(u32, axis=1)], axis=1)
    t = jnp.arange(s)
    outs = []
    for g, w in enumerate(C_WINDOWS):
        sl = slice(g * C_GROUP_DIM, (g + 1) * C_GROUP_DIM)
        csg = cs[..., sl]
        lo = jnp.maximum(t + 1 - w, 0)
        total = csg[:, 1:] - csg[:, lo]
        count = jnp.minimum(t + 1, w).astype(jnp.float32)
        outs.append(total / count[None, :, None] - u32[..., sl])
    pooled = jnp.stack(outs, axis=2)
    mixed = jnp.einsum('bsgc,gce->bsge', pooled, w_group.astype(jnp.float32)).reshape(b, s, c)
    return (mixed * scale.astype(jnp.float32)).astype(u.dtype)


def even_mixer(h, positions, w_in, q_norm, w_q_up, kv_norm, w_kv_up, w_out):
    b, s, _ = h.shape
    proj = h @ w_in
    offs = [int(o) for o in np.cumsum(EVEN_SPLITS)[:-1]]
    qa, ka, va, c_q, c_kv, k_rope = jnp.split(proj, offs, axis=-1)
    out_a = dilated_attention(rope(split_heads(qa, A_HEADS), positions),
                              rope(split_heads(ka, A_HEADS), positions),
                              split_heads(va, A_HEADS))
    qb = split_heads(rms_norm(c_q, q_norm) @ w_q_up, B_HEADS)
    q_nope, q_pe = qb[..., :B_NOPE], qb[..., B_NOPE:]
    kv = split_heads(rms_norm(c_kv, kv_norm) @ w_kv_up, B_HEADS)
    k_nope, v_b = kv[..., :B_NOPE], kv[..., B_NOPE:]
    k_pe = rope(k_rope[:, None], positions)
    q_full = jnp.concatenate([q_nope, rope(q_pe, positions)], axis=-1)
    k_full = jnp.concatenate([k_nope, jnp.broadcast_to(k_pe, (b, B_HEADS, s, B_ROPE))], axis=-1)
    out_b = causal_softmax_attention(q_full, k_full, v_b)
    merged = merge_heads(jnp.concatenate([out_a, out_b], axis=1))
    return merged @ w_out


def odd_mixer(h, w_in, pool_w, pool_scale, w_out):
    proj = h @ w_in
    offs = [int(o) for o in np.cumsum(ODD_SPLITS)[:-1]]
    u, qd, kd, vd = jnp.split(proj, offs, axis=-1)
    out_c = pool_mixer(u, pool_w, pool_scale)
    out_d = merge_heads(stick_breaking_attention(split_heads(qd, D_HEADS), split_heads(kd, D_HEADS),
                                                 split_heads(vd, D_HEADS)))
    return jnp.concatenate([out_c, out_d], axis=-1) @ w_out


def setup_inputs(seed: int = 0) -> dict:
    key = jax.random.key(seed)
    ks = jax.random.split(key, 20)
    f32 = jnp.float32

    def nrm(k, shape, fan_in):
        return jax.random.normal(k, shape, f32) * (fan_in ** -0.5)

    def gain(k, shape):
        return 1.0 + 0.02 * jax.random.normal(k, shape, f32)

    x = jax.random.normal(ks[0], (BATCH, SEQ, D_MODEL), f32)
    offsets = jax.random.randint(ks[1], (BATCH, 1), 0, 4096, dtype=jnp.int32)
    positions = (jnp.arange(SEQ, dtype=jnp.int32)[None, :] + offsets).astype(jnp.int32)
    return {
        "x": x,
        "positions": positions,
        "norm_g": gain(ks[2], (DEPTH, 3, D_MODEL)),
        "ffn_w_gate": nrm(ks[3], (DEPTH, 2, D_MODEL, D_FF), D_MODEL),
        "ffn_w_up": nrm(ks[4], (DEPTH, 2, D_MODEL, D_FF), D_MODEL),
        "ffn_w_down": nrm(ks[5], (DEPTH, 2, D_FF, D_MODEL), D_FF),
        "even_w_in": nrm(ks[6], (N_EVEN, D_MODEL, IN_EVEN), D_MODEL),
        "even_q_norm": gain(ks[7], (N_EVEN, B_Q_LORA)),
        "even_w_q_up": nrm(ks[8], (N_EVEN, B_Q_LORA, B_HEADS * (B_NOPE + B_ROPE)), B_Q_LORA),
        "even_kv_norm": gain(ks[9], (N_EVEN, B_KV_LORA)),
        "even_w_kv_up": nrm(ks[10], (N_EVEN, B_KV_LORA, B_HEADS * (B_NOPE + B_V)), B_KV_LORA),
        "even_w_out": nrm(ks[11], (N_EVEN, D_MIX_EVEN, D_MODEL), D_MIX_EVEN),
        "odd_w_in": nrm(ks[12], (N_ODD, D_MODEL, IN_ODD), D_MODEL),
        "odd_pool_w": nrm(ks[13], (N_ODD, C_GROUPS, C_GROUP_DIM, C_GROUP_DIM), C_GROUP_DIM),
        "odd_pool_scale": gain(ks[14], (N_ODD, C_WIDTH)),
        "odd_w_out": nrm(ks[15], (N_ODD, D_MIX_ODD, D_MODEL), D_MIX_ODD),
        "final_norm": gain(ks[16], (D_MODEL,)),
    }


def reference(x, positions, norm_g, ffn_w_gate, ffn_w_up, ffn_w_down, even_w_in, even_q_norm, even_w_q_up,
              even_kv_norm, even_w_kv_up, even_w_out, odd_w_in, odd_pool_w, odd_pool_scale, odd_w_out,
              final_norm):
    h = x
    for i in range(DEPTH):
        h = h + 0.5 * swiglu(rms_norm(h, norm_g[i, 0]), ffn_w_gate[i, 0], ffn_w_up[i, 0], ffn_w_down[i, 0])
        hn = rms_norm(h, norm_g[i, 1])
        if i % 2 == 0:
            e = i // 2
            mix = even_mixer(hn, positions, even_w_in[e], even_q_norm[e], even_w_q_up[e], even_kv_norm[e],
                             even_w_kv_up[e], even_w_out[e])
        else:
            o = i // 2
            mix = odd_mixer(hn, odd_w_in[o], odd_pool_w[o], odd_pool_scale[o], odd_w_out[o])
        h = h + mix
        h = h + 0.5 * swiglu(rms_norm(h, norm_g[i, 2]), ffn_w_gate[i, 1], ffn_w_up[i, 1], ffn_w_down[i, 1])
    return rms_norm(h, final_norm)
```

```cpp
#include <hip/hip_runtime.h>
#include <hip/hip_cooperative_groups.h>
#include <cstdio>
#include <cstdint>
namespace cg = cooperative_groups;

#ifndef PMASK
#define PMASK 0x1ffff
#endif
#define PON(k) ((PMASK >> (k)) & 1)
#ifndef DUPSTEP
#define DUPSTEP -1
#endif
#ifndef REP5
#define REP5 1
#endif
#ifndef REP12
#define REP12 1
#endif
#ifndef ONE_LAUNCH
#define ONE_LAUNCH 1
#endif

#define LAS __attribute__((address_space(3)))
#define GAS __attribute__((address_space(1)))
typedef unsigned short bf16_t;
typedef short bf16x8 __attribute__((ext_vector_type(8)));
typedef short s16x4 __attribute__((ext_vector_type(4)));
typedef float f32x4 __attribute__((ext_vector_type(4)));
typedef float f32x2 __attribute__((ext_vector_type(2)));
typedef float f32x16 __attribute__((ext_vector_type(16)));
typedef unsigned u32x4 __attribute__((ext_vector_type(4)));
typedef unsigned u32x2 __attribute__((ext_vector_type(2)));
typedef __bf16 bf16x2_t __attribute__((ext_vector_type(2)));

constexpr int SEQ = 16384, NB = 2, M = NB * SEQ, D = 2048, FF = 1536;
constexpr int INE = 3072  , INO = 2048, DME = 1280, DMO = 1024;
constexpr float EPS = 1e-6f;
constexpr float LOG2E = 1.4426950408889634f, LN2 = 0.6931471805599453f;
constexpr float L2THETA = 13.287712379549449f;
constexpr float QSCALE_A = 0.08838834764831845f * LOG2E;
constexpr float QSCALE_B = 0.10206207261596577f * LOG2E;
constexpr float QSCALE_D = 0.08838834764831845f * LOG2E;

constexpr size_t MiB = 1u << 20;
constexpr size_t WS_WGU = 0;
constexpr size_t WS_WD = WS_WGU + 48 * MiB;
constexpr size_t WS_WINE = WS_WD + 24 * MiB;
constexpr size_t WS_WINO = WS_WINE + 12 * MiB;
constexpr size_t WS_WQUP = WS_WINO + 8 * MiB;
constexpr size_t WS_WKVUP = WS_WQUP + 1 * MiB;
constexpr size_t WS_WOUTE = WS_WKVUP + 1 * MiB;
constexpr size_t WS_WOUTO = WS_WOUTE + 5 * MiB;
constexpr size_t WS_POOLW = WS_WOUTO + 4 * MiB;
constexpr size_t WS_HB = WS_POOLW + 1 * MiB;
constexpr size_t WS_ACT = WS_HB + 128 * MiB;
constexpr size_t WS_PROJ = WS_ACT + 96 * MiB;
constexpr size_t WS_QF = WS_PROJ + 192 * MiB;
constexpr size_t WS_KF = WS_QF + 24 * MiB;
constexpr size_t WS_VB = WS_KF + 24 * MiB;
constexpr size_t WS_MRG = WS_VB + 32 * MiB;
constexpr size_t WS_SSQ = WS_MRG + 80 * MiB;
constexpr size_t WS_STE = WS_SSQ + 4 * MiB;
constexpr size_t WS_BAR = WS_STE + 3 * MiB;
constexpr size_t WS_END = WS_BAR + 1 * MiB;

__device__ __forceinline__ unsigned cvt_pk_bf16(float lo, float hi) { unsigned r; asm volatile("v_cvt_pk_bf16_f32 %0, %1, %2" : "=v"(r) : "v"(lo), "v"(hi)); return r; }
__device__ __forceinline__ float bf_lo(unsigned u) { return __builtin_bit_cast(float, u << 16); }
__device__ __forceinline__ float bf_hi(unsigned u) { return __builtin_bit_cast(float, u & 0xffff0000u); }
__device__ __forceinline__ u32x4 pack8(const float* v) { u32x4 w; w.x = cvt_pk_bf16(v[0], v[1]); w.y = cvt_pk_bf16(v[2], v[3]); w.z = cvt_pk_bf16(v[4], v[5]); w.w = cvt_pk_bf16(v[6], v[7]); return w; }
__device__ __forceinline__ float wave_sum(float v) {
#pragma unroll
    for (int o = 1; o < 64; o <<= 1) v += __shfl_xor(v, o);
    return v;
}
__device__ __forceinline__ void sincos_rev(float ang, float& s, float& c) {
    const float chi = 0.15915494309189535f, clo = -1.7182170e-9f * 0.0f + (float)(0.15915494309189535 - (double)0.15915494309189535f);
    const float rh = ang * chi; const float err = __builtin_fmaf(ang, chi, -rh) + ang * clo;
    float fr = (rh - __builtin_floorf(rh)) + err;
    s = __builtin_amdgcn_sinf(fr); c = __builtin_amdgcn_cosf(fr);
}

namespace pg8 {
constexpr int BM = 256, BK = 64, HALF = 128, HTB = HALF * BK * 2, STAGE_BYTES = 8 * HTB, NXCD = 8, WGM = 4;
__host__ __device__ __forceinline__ int lds_byte(int r, int c) { const int st = (r >> 4) * 2 + (c >> 5), rr = r & 15, cc = c & 31, ob = rr * 64 + cc * 2; return st * 1024 + (ob ^ (((ob >> 9) & 1) << 5)); }
__host__ __device__ __forceinline__ void stage_rc(int b, int& R, int& C) { const int st = b / 1024, sb = b % 1024, swz = sb ^ (((sb >> 9) & 1) << 5); R = (st >> 1) * 16 + swz / 64; C = (st & 1) * 32 + (swz % 64) / 2; }
__host__ __device__ __forceinline__ int perm32(int rho) { const int n = rho >> 4, i = rho & 15; return 8 * (i >> 2) + 4 * n + (i & 3); }

struct Unit { int pm, pn; };
struct Gemm { const bf16_t* A; const bf16_t* Bt; int M, N, K, lda, ldb; };

struct StaticOrder {
    int nM, nN, nwg, G, c;
    __host__ __device__ void init(int M_, int N_, int G_, int c_) { nM = M_ / BM; nN = N_ / BM; nwg = nM * nN; G = G_; c = c_; }
    __host__ __device__ bool next(int i, Unit& u) const {
        const long L = (long)i * G + c; if (L >= nwg) return false;
        int wgid = (int)L; { const int q = nwg / NXCD, r = nwg % NXCD, xcd = wgid % NXCD, off = wgid / NXCD; wgid = (xcd < r ? xcd * (q + 1) : r * (q + 1) + (xcd - r) * q) + off; }
        const int nig = WGM * nN, gid = wgid / nig, fm = gid * WGM, gsz = (nM - fm) < WGM ? (nM - fm) : WGM;
        u.pm = fm + ((wgid % nig) % gsz); u.pn = (wgid % nig) / gsz; return true;
    }
};

template <class Epi>
__device__ __forceinline__ void gemm_phase(LAS unsigned char* lds, const Gemm g, const StaticOrder& S, const Epi& E) {
    int tid = threadIdx.x; asm volatile("" : "+v"(tid));
    const int wid = __builtin_amdgcn_readfirstlane(tid >> 6), lane = tid & 63, wr = wid >> 2, wc = wid & 3, fr = lane & 15, fq = lane >> 4;
    int K = g.K; asm volatile("" : "+s"(K));
    const int nt = K / BK;
    unsigned voffA[2], voffB[2];
#pragma unroll
    for (int i = 0; i < 2; ++i) { int R, C; stage_rc(tid * 16 + i * 8192, R, C); const int Rb = (R & ~31) + perm32(R & 31);
        voffA[i] = (unsigned)(R * g.lda + C) * 2u; voffB[i] = (unsigned)(Rb * g.ldb + C) * 2u; }
    const size_t kstep = (size_t)(BK * 2);
    const size_t hstepA = (size_t)HALF * g.lda * 2, hstepB = (size_t)HALF * g.ldb * 2;
    const size_t tstepA = 2 * hstepA, tstepB = 2 * hstepB;
    const unsigned ldsw = (unsigned)wid * 1024u;
    const int aoff = lds_byte(wr * 64 + fr, fq * 8), boff = lds_byte(wc * 32 + fr, fq * 8);
#define PG8_SA(b, h) (((b) * 2 + (h)) * HTB)
#define PG8_SB(b, h) ((4 + (b) * 2 + (h)) * HTB)
#define PG8_STAGE(bufoff, gbase, voff) do { _Pragma("unroll") for (int _i = 0; _i < 2; ++_i) \
        __builtin_amdgcn_global_load_lds((const unsigned*)((const char*)(gbase) + (voff)[_i]), (LAS unsigned*)(lds + (bufoff) + ldsw + _i * 8192), 16, 0, 0); } while (0)
#define PG8_LDA(dst, b, h) do { _Pragma("unroll") for (int m = 0; m < 4; ++m) _Pragma("unroll") for (int k = 0; k < 2; ++k) dst[m][k] = *(const LAS bf16x8*)(lds + PG8_SA(b, h) + aoff + m * 2048 + k * 1024); } while (0)
#define PG8_LDB(dst, b, h) do { _Pragma("unroll") for (int n = 0; n < 2; ++n) _Pragma("unroll") for (int k = 0; k < 2; ++k) dst[n][k] = *(const LAS bf16x8*)(lds + PG8_SB(b, h) + boff + n * 2048 + k * 1024); } while (0)
#define PG8_MMA(ai, bj, At, Bt) do { __builtin_amdgcn_s_setprio(1); _Pragma("unroll") for (int m = 0; m < 4; ++m) _Pragma("unroll") for (int n = 0; n < 2; ++n) _Pragma("unroll") for (int k = 0; k < 2; ++k) \
        acc[ai][bj][m][n] = __builtin_amdgcn_mfma_f32_16x16x32_bf16(Bt[n][k], At[m][k], acc[ai][bj][m][n], 0, 0, 0); __builtin_amdgcn_s_setprio(0); } while (0)
#define PG8_WAIT_V(n) asm volatile("s_waitcnt vmcnt(" #n ")" ::: "memory")
#define PG8_WAIT_L(n) asm volatile("s_waitcnt lgkmcnt(" #n ")" ::: "memory")
#define PG8_BAR __builtin_amdgcn_s_barrier()
#define PG8_SCHED __builtin_amdgcn_sched_barrier(0)
    Unit cur, nxt; int ui = 0;
    if (!S.next(0, cur)) return;
    f32x4 acc[2][2][4][2];
#pragma unroll
    for (int a = 0; a < 2; ++a)
#pragma unroll
        for (int b = 0; b < 2; ++b)
#pragma unroll
            for (int m = 0; m < 4; ++m)
#pragma unroll
                for (int n = 0; n < 2; ++n) acc[a][b][m][n] = (f32x4){0.f, 0.f, 0.f, 0.f};
    bf16x8 At[4][2], B0[2][2], B1[2][2];
    const char* cA = (const char*)g.A + (size_t)cur.pm * tstepA; const char* cB = (const char*)g.Bt + (size_t)cur.pn * tstepB;
    PG8_STAGE(PG8_SB(0, 0), cB, voffB); PG8_STAGE(PG8_SB(0, 1), cB + hstepB, voffB); PG8_STAGE(PG8_SA(0, 0), cA, voffA); PG8_STAGE(PG8_SA(0, 1), cA + hstepA, voffA);
    if (wr == 1) PG8_BAR;
    PG8_WAIT_V(2); PG8_BAR;
    PG8_STAGE(PG8_SB(1, 0), cB + kstep, voffB); PG8_STAGE(PG8_SA(1, 0), cA + kstep, voffA); PG8_STAGE(PG8_SB(1, 1), cB + hstepB + kstep, voffB);
    PG8_WAIT_V(6); PG8_BAR;
    for (;;) {
        const bool has_next = S.next(ui + 1, nxt);
        const char* nA = has_next ? (const char*)g.A + (size_t)nxt.pm * tstepA : cA; const char* nB = has_next ? (const char*)g.Bt + (size_t)nxt.pn * tstepB : cB;
#pragma unroll 1
        for (int t = 0; t < nt; t += 2) {
            const bool last = (t == nt - 2);
            const char* a1 = cA + (size_t)(t + 1) * kstep;
            const char* a2 = last ? nA : cA + (size_t)(t + 2) * kstep; const char* b2 = last ? nB : cB + (size_t)(t + 2) * kstep;
            const char* a3 = a2 + kstep; const char* b3 = b2 + kstep;
            PG8_LDB(B0, 0, 0); PG8_LDB(B1, 0, 1); PG8_SCHED; PG8_LDA(At, 0, 0); PG8_STAGE(PG8_SA(1, 1), a1 + hstepA, voffA);
            PG8_WAIT_V(8); PG8_WAIT_L(0); PG8_BAR; PG8_MMA(0, 0, At, B0); PG8_MMA(0, 1, At, B1); PG8_BAR; PG8_SCHED;
            PG8_LDA(At, 0, 1); PG8_STAGE(PG8_SB(0, 0), b2, voffB); PG8_STAGE(PG8_SB(0, 1), b2 + hstepB, voffB); PG8_STAGE(PG8_SA(0, 0), a2, voffA);
            PG8_WAIT_V(8); PG8_WAIT_L(0); PG8_BAR; PG8_MMA(1, 0, At, B0); PG8_MMA(1, 1, At, B1); PG8_BAR; PG8_SCHED;
            PG8_LDB(B0, 1, 0); PG8_LDB(B1, 1, 1); PG8_SCHED; PG8_LDA(At, 1, 0); PG8_STAGE(PG8_SA(0, 1), a2 + hstepA, voffA);
            PG8_WAIT_V(8); PG8_WAIT_L(0); PG8_BAR; PG8_MMA(0, 0, At, B0); PG8_MMA(0, 1, At, B1); PG8_BAR; PG8_SCHED;
            PG8_LDA(At, 1, 1); PG8_STAGE(PG8_SB(1, 0), b3, voffB); PG8_STAGE(PG8_SB(1, 1), b3 + hstepB, voffB); PG8_STAGE(PG8_SA(1, 0), a3, voffA);
            PG8_WAIT_V(8); PG8_WAIT_L(0); PG8_BAR; PG8_MMA(1, 0, At, B0); PG8_MMA(1, 1, At, B1); PG8_BAR; PG8_SCHED;
        }
        E(acc, cur, wr, wc, fr, fq);
        if (!has_next) break;
#pragma unroll
        for (int a = 0; a < 2; ++a)
#pragma unroll
            for (int b = 0; b < 2; ++b)
#pragma unroll
                for (int m = 0; m < 4; ++m)
#pragma unroll
                    for (int n = 0; n < 2; ++n) acc[a][b][m][n] = (f32x4){0.f, 0.f, 0.f, 0.f};
        cur = nxt; cA = nA; cB = nB; ++ui;
    }
    PG8_WAIT_V(0);
    if (wr == 0) PG8_BAR;
    PG8_BAR;
#undef PG8_SA
#undef PG8_SB
#undef PG8_STAGE
#undef PG8_LDA
#undef PG8_LDB
#undef PG8_MMA
#undef PG8_WAIT_V
#undef PG8_WAIT_L
#undef PG8_BAR
#undef PG8_SCHED
}
}
using pg8::Unit;

typedef f32x4 Acc[2][2][4][2];

template <int LD, int S0, int NS>
__device__ __forceinline__ void rows_rstd(const float* st, int row0, int fq, float inv_n, float (&r)[2][4]) {
#pragma unroll
    for (int ai = 0; ai < 2; ++ai)
#pragma unroll
        for (int m = 0; m < 4; ++m) {
            const GAS float* p = (const GAS float*)st + (size_t)(row0 + ai * 128 + m * 16) * LD + S0;
            float s = 0.f;
            if (NS == 32) { const f32x4 a = *(const GAS f32x4*)(p + fq * 8), b = *(const GAS f32x4*)(p + fq * 8 + 4); s = (a.x + a.y) + (a.z + a.w) + (b.x + b.y) + (b.z + b.w); }
            else { if (fq * 4 < NS) { const f32x4 a = *(const GAS f32x4*)(p + fq * 4); s = (a.x + a.y) + (a.z + a.w); } }
            s += __shfl_xor(s, 16); s += __shfl_xor(s, 32);
            r[ai][m] = 1.0f / sqrtf(s * inv_n + EPS);
        }
}

struct EpiSwiglu {
    const float* ssq; bf16_t* act;
    __device__ __forceinline__ void operator()(const Acc& acc, const Unit& u, int wr, int wc, int fr, int fq) const {
        asm volatile("" : "+v"(fr), "+v"(fq));
        const int row0 = u.pm * 256 + wr * 64 + fr, col = u.pn * 128 + wc * 32 + 8 * fq;
        float rs[2][4]; rows_rstd<32, 0, 32>(ssq, row0, fq, 1.0f / D, rs);
#pragma unroll
        for (int ai = 0; ai < 2; ++ai)
#pragma unroll
            for (int m = 0; m < 4; ++m) { const float r = rs[ai][m]; float o[8];
#pragma unroll
                for (int n = 0; n < 2; ++n)
#pragma unroll
                    for (int j = 0; j < 4; ++j) { const float g = acc[ai][0][m][n][j] * r, up = acc[ai][1][m][n][j] * r;
                        o[4 * n + j] = g * __builtin_amdgcn_rcpf(1.0f + __builtin_amdgcn_exp2f(-g * LOG2E)) * up; }
                *(GAS u32x4*)((GAS bf16_t*)act + (size_t)(row0 + ai * 128 + m * 16) * FF + col) = pack8(o); __builtin_amdgcn_sched_barrier(0); }
    }
};

struct EpiResid {
    bf16_t* hb; float* ssq; float coef;
    __device__ __forceinline__ void operator()(const Acc& acc, const Unit& u, int wr, int wc, int fr, int fq) const {
        asm volatile("" : "+v"(fr), "+v"(fq));
        const int row0 = u.pm * 256 + wr * 64 + fr, col0 = u.pn * 256 + wc * 32 + 8 * fq;
        GAS bf16_t* hg = (GAS bf16_t*)hb;
#pragma unroll
        for (int ai = 0; ai < 2; ++ai) {
            u32x4 hv[4][2];
#pragma unroll
            for (int m = 0; m < 4; ++m)
#pragma unroll
                for (int bj = 0; bj < 2; ++bj) hv[m][bj] = *(const GAS u32x4*)(hg + (size_t)(row0 + ai * 128 + m * 16) * D + col0 + bj * 128);
            __builtin_amdgcn_sched_barrier(0);
#pragma unroll
            for (int m = 0; m < 4; ++m) { const int row = row0 + ai * 128 + m * 16; float ss = 0.f;
#pragma unroll
                for (int bj = 0; bj < 2; ++bj) { const size_t off = (size_t)row * D + col0 + bj * 128; const u32x4 hh = hv[m][bj];
                    const f32x4 h0 = (f32x4){bf_lo(hh.x), bf_hi(hh.x), bf_lo(hh.y), bf_hi(hh.y)}, h1 = (f32x4){bf_lo(hh.z), bf_hi(hh.z), bf_lo(hh.w), bf_hi(hh.w)};
                    const f32x4 v0 = h0 + coef * acc[ai][bj][m][0], v1 = h1 + coef * acc[ai][bj][m][1];
                    u32x4 w; w.x = cvt_pk_bf16(v0[0], v0[1]); w.y = cvt_pk_bf16(v0[2], v0[3]); w.z = cvt_pk_bf16(v1[0], v1[1]); w.w = cvt_pk_bf16(v1[2], v1[3]);
                    *(GAS u32x4*)(hg + off) = w;
                    ss += (v0[0] * v0[0] + v0[1] * v0[1]) + (v0[2] * v0[2] + v0[3] * v0[3]) + (v1[0] * v1[0] + v1[1] * v1[1]) + (v1[2] * v1[2] + v1[3] * v1[3]); }
                ss += __shfl_xor(ss, 16); ss += __shfl_xor(ss, 32);
                if (fq == 0) ((GAS float*)ssq)[(size_t)row * 32 + u.pn * 4 + wc] = ss; }
            __builtin_amdgcn_sched_barrier(0);
        }
    }
};

__device__ __forceinline__ void rope4(float pos, const float (&inv)[4], float* lo, float* hi) {
#pragma unroll
    for (int j = 0; j < 4; ++j) { float s, c; sincos_rev(pos * inv[j], s, c); const float a = lo[j], b = hi[j]; lo[j] = a * c - b * s; hi[j] = b * c + a * s; }
}

struct EpiInEven {
    const float* ssq; const int* pos; bf16_t* proj; float* ste; bf16_t* kf;
    __device__ __forceinline__ void operator()(const Acc& acc, const Unit& u, int wr, int wc, int fr, int fq) const {
        asm volatile("" : "+v"(fr), "+v"(fq));
        const int row0 = u.pm * 256 + wr * 64 + fr, pn = u.pn, colw = pn * 256 + wc * 32 + 8 * fq;
        float rs[2][4]; rows_rstd<32, 0, 32>(ssq, row0, fq, 1.0f / D, rs);
        if (pn < 6) {
            const float qs = pn < 3 ? QSCALE_A : 1.0f;
            float inv[4];
#pragma unroll
            for (int j = 0; j < 4; ++j) inv[j] = __builtin_amdgcn_exp2f(-(float)(16 * wc + 4 * fq + j) * (L2THETA / 64.0f));
#pragma unroll
            for (int ai = 0; ai < 2; ++ai)
#pragma unroll
                for (int m = 0; m < 4; ++m) { const int row = row0 + ai * 128 + m * 16; const float p = (float)((const GAS int*)pos)[row], sc = rs[ai][m] * qs;
                    float sn[4], cs[4];
#pragma unroll
                    for (int j = 0; j < 4; ++j) sincos_rev(p * inv[j], sn[j], cs[j]);
#pragma unroll
                    for (int bj = 0; bj < 2; ++bj) { float o[8];
#pragma unroll
                        for (int j = 0; j < 4; ++j) { const float a = acc[ai][bj][m][0][j] * sc, b = acc[ai][bj][m][1][j] * sc; o[j] = a * cs[j] - b * sn[j]; o[4 + j] = b * cs[j] + a * sn[j]; }
                        *(GAS u32x4*)((GAS bf16_t*)proj + (size_t)row * INE + colw + bj * 128) = pack8(o); } __builtin_amdgcn_sched_barrier(0); }
        } else {
            float inv[4];
#pragma unroll
            for (int j = 0; j < 4; ++j) inv[j] = __builtin_amdgcn_exp2f(-(float)(4 * fq + j) * (L2THETA / 16.0f));
#pragma unroll
            for (int ai = 0; ai < 2; ++ai)
#pragma unroll
                for (int m = 0; m < 4; ++m) { const int row = row0 + ai * 128 + m * 16; const float r = rs[ai][m];
#pragma unroll
                    for (int bj = 0; bj < 2; ++bj) { float o[8]; float ss = 0.f;
#pragma unroll
                        for (int n = 0; n < 2; ++n)
#pragma unroll
                            for (int j = 0; j < 4; ++j) { o[4 * n + j] = acc[ai][bj][m][n][j] * r; ss += o[4 * n + j] * o[4 * n + j]; }
                        if (pn == 11 && bj == 1) {
                            if (wc == 0) { rope4((float)((const GAS int*)pos)[row], inv, o, o + 4); const u32x4 w = pack8(o);
#pragma unroll
                                for (int hh = 0; hh < 4; ++hh) *(GAS u32x4*)((GAS bf16_t*)kf + (size_t)row * 384 + hh * 96 + 64 + 8 * fq) = w; }
                        } else {
                            *(GAS u32x4*)((GAS bf16_t*)proj + (size_t)row * INE + colw + bj * 128) = pack8(o);
                            if (pn >= 9) { ss += __shfl_xor(ss, 16); ss += __shfl_xor(ss, 32); if (fq == 0) ((GAS float*)ste)[(size_t)row * 24 + (pn - 9) * 8 + bj * 4 + wc] = ss; }
                        } } __builtin_amdgcn_sched_barrier(0); }
        }
    }
};

struct EpiQup {
    const float* ste; const int* pos; bf16_t* qf;
    __device__ __forceinline__ void operator()(const Acc& acc, const Unit& u, int wr, int wc, int fr, int fq) const {
        asm volatile("" : "+v"(fr), "+v"(fq));
        const int row0 = u.pm * 256 + wr * 64 + fr;
        float rs[2][4]; rows_rstd<24, 0, 12>(ste, row0, fq, 1.0f / 384.0f, rs);
        float inv[4];
#pragma unroll
        for (int j = 0; j < 4; ++j) inv[j] = __builtin_amdgcn_exp2f(-(float)(4 * fq + j) * (L2THETA / 16.0f));
#pragma unroll
        for (int bj = 0; bj < 2; ++bj) { const int g = 8 * u.pn + 4 * bj + wc; if (g >= 12) continue; const int hd = g / 3, part = g - 3 * hd;
#pragma unroll
            for (int ai = 0; ai < 2; ++ai)
#pragma unroll
                for (int m = 0; m < 4; ++m) { const int row = row0 + ai * 128 + m * 16; const float r = rs[ai][m] * QSCALE_B; float o[8];
#pragma unroll
                    for (int n = 0; n < 2; ++n)
#pragma unroll
                        for (int j = 0; j < 4; ++j) o[4 * n + j] = acc[ai][bj][m][n][j] * r;
                    if (part == 2) rope4((float)((const GAS int*)pos)[row], inv, o, o + 4);
                    *(GAS u32x4*)((GAS bf16_t*)qf + (size_t)row * 384 + hd * 96 + part * 32 + 8 * fq) = pack8(o); __builtin_amdgcn_sched_barrier(0); } }
    }
};

struct EpiKvup {
    const float* ste; bf16_t* kf; bf16_t* vb;
    __device__ __forceinline__ void operator()(const Acc& acc, const Unit& u, int wr, int wc, int fr, int fq) const {
        asm volatile("" : "+v"(fr), "+v"(fq));
        const int row0 = u.pm * 256 + wr * 64 + fr;
        float rs[2][4]; rows_rstd<24, 12, 8>(ste, row0, fq, 1.0f / 256.0f, rs);
#pragma unroll
        for (int bj = 0; bj < 2; ++bj) { const int g = 8 * u.pn + 4 * bj + wc; const int hd = g / 6, part = g - 6 * hd;
#pragma unroll
            for (int ai = 0; ai < 2; ++ai)
#pragma unroll
                for (int m = 0; m < 4; ++m) { const int row = row0 + ai * 128 + m * 16; const float r = rs[ai][m]; float o[8];
#pragma unroll
                    for (int n = 0; n < 2; ++n)
#pragma unroll
                        for (int j = 0; j < 4; ++j) o[4 * n + j] = acc[ai][bj][m][n][j] * r;
                    bf16_t* dst = part < 2 ? kf + (size_t)row * 384 + hd * 96 + part * 32 + 8 * fq : vb + (size_t)row * 512 + hd * 128 + (part - 2) * 32 + 8 * fq;
                    *(GAS u32x4*)(GAS bf16_t*)dst = pack8(o); __builtin_amdgcn_sched_barrier(0); } }
    }
};

struct EpiInOdd {
    const float* ssq; bf16_t* proj;
    __device__ __forceinline__ void operator()(const Acc& acc, const Unit& u, int wr, int wc, int fr, int fq) const {
        asm volatile("" : "+v"(fr), "+v"(fq));
        const int row0 = u.pm * 256 + wr * 64 + fr, colw = u.pn * 256 + wc * 32 + 8 * fq;
        float rs[2][4]; rows_rstd<32, 0, 32>(ssq, row0, fq, 1.0f / D, rs);
        const float qs = (u.pn == 2 || u.pn == 3) ? QSCALE_D : 1.0f;
#pragma unroll
        for (int ai = 0; ai < 2; ++ai)
#pragma unroll
            for (int m = 0; m < 4; ++m) { const int row = row0 + ai * 128 + m * 16; const float r = rs[ai][m] * qs;
#pragma unroll
                for (int bj = 0; bj < 2; ++bj) { float o[8];
#pragma unroll
                    for (int n = 0; n < 2; ++n)
#pragma unroll
                        for (int j = 0; j < 4; ++j) o[4 * n + j] = acc[ai][bj][m][n][j] * r;
                    *(GAS u32x4*)((GAS bf16_t*)proj + (size_t)row * INO + colw + bj * 128) = pack8(o); } __builtin_amdgcn_sched_barrier(0); }
    }
};

template <int MODE>
__device__ __forceinline__ void tile_desc(int i, int u0, int r4, int& tok0, int& st, int& dil) {
    if (MODE == 0) {
        if (i < 18) { dil = 1; st = 1; tok0 = 4 * u0 - 128 + 64 * i; }
        else if (i < 24) { const int j = i - 18; dil = 4; st = 4; tok0 = r4 + 4 * (u0 - 128 + 64 * j); }
        else { const int j = i - 24, c = j / 3, jj = j - 3 * c; dil = 16; st = 16; tok0 = r4 + 4 * c + 16 * (u0 / 4 - 128 + 64 * jj); }
    } else { dil = 1; st = 1; tok0 = 64 * i; }
}
__device__ __forceinline__ float xhalf(float v, int h) { const unsigned u = __builtin_bit_cast(unsigned, v); auto rr = __builtin_amdgcn_permlane32_swap(u, u, false, false);
    return __builtin_bit_cast(float, h == 0 ? (unsigned)rr[1] : (unsigned)rr[0]); }
__device__ __forceinline__ s16x4 vtr(const LAS unsigned char* p) { return __builtin_bit_cast(s16x4, __builtin_amdgcn_ds_read_tr16_b64_v4i16((LAS s16x4*)p)); }

template <int MODE>
__device__ __forceinline__ void att_smpv(f32x16 (&s)[2], f32x16 (&o)[4], float& mrun, float& lrun, float& Rrun, int tq, int tqmin, int tok0, int st, int dil, int h, int lane, const LAS unsigned char* vb) {
    const int d0 = tq - tok0 - st * 4 * h;
    bf16x8 pf[2][2];
#define ATT_PACK(src, kk) do { _Pragma("unroll") for (int s2 = 0; s2 < 2; ++s2) { u32x4 w_; w_.x = cvt_pk_bf16(src[8 * s2], src[8 * s2 + 1]); w_.y = cvt_pk_bf16(src[8 * s2 + 2], src[8 * s2 + 3]); \
            w_.z = cvt_pk_bf16(src[8 * s2 + 4], src[8 * s2 + 5]); w_.w = cvt_pk_bf16(src[8 * s2 + 6], src[8 * s2 + 7]); pf[kk][s2] = __builtin_bit_cast(bf16x8, w_); } } while (0)
    if (MODE != 2) {
        const bool need_mask = (MODE == 0) || (tok0 + 63 > tqmin);
        if (need_mask) {
#pragma unroll
            for (int kk = 0; kk < 2; ++kk)
#pragma unroll
                for (int e = 0; e < 16; ++e) { const int d = d0 - st * (32 * kk + 8 * (e >> 2) + (e & 3));
                    const bool ok = (MODE == 0) ? ((unsigned)d <= 128u * (unsigned)dil && (d & (dil - 1)) == 0) : (d >= 0);
                    s[kk][e] = ok ? s[kk][e] : -INFINITY; }
        }
        float mx = fmaxf(fmaxf(s[0][0], s[1][0]), fmaxf(s[0][1], s[1][1]));
#pragma unroll
        for (int e = 2; e < 16; e += 2) { mx = fmaxf(fmaxf(mx, s[0][e]), s[1][e]); mx = fmaxf(fmaxf(mx, s[0][e + 1]), s[1][e + 1]); }
        mx = fmaxf(mx, xhalf(mx, h));
        if (__any(mx > mrun)) {
            const float mnew = fmaxf(mrun, mx), alpha = __builtin_amdgcn_exp2f(mrun - mnew); mrun = mnew; lrun *= alpha;
#pragma unroll
            for (int b = 0; b < 4; ++b)
#pragma unroll
                for (int e = 0; e < 16; ++e) o[b][e] *= alpha;
        }
        f32x2 ps2 = (f32x2){0.f, 0.f};
#pragma unroll
        for (int kk = 0; kk < 2; ++kk)
#pragma unroll
            for (int e = 0; e < 16; e += 2) { const float p0 = __builtin_amdgcn_exp2f(s[kk][e] - mrun), p1 = __builtin_amdgcn_exp2f(s[kk][e + 1] - mrun); s[kk][e] = p0; s[kk][e + 1] = p1; ps2 += (f32x2){p0, p1}; }
        lrun += ps2.x + ps2.y;
        ATT_PACK(s[0], 0); ATT_PACK(s[1], 1);
    } else {
        float run = Rrun;
        const bool need_mask = tok0 + 63 >= tqmin;
#pragma unroll
        for (int kk = 1; kk >= 0; --kk) {
            if (need_mask) {
#pragma unroll
                for (int e = 0; e < 16; ++e) { const int d = d0 - st * (32 * kk + 8 * (e >> 2) + (e & 3)); s[kk][e] = d > 0 ? s[kk][e] : -INFINITY; }
            }
            float zm = fmaxf(fmaxf(s[kk][0], s[kk][1]), s[kk][2]);
#pragma unroll
            for (int e = 3; e < 15; e += 2) zm = fmaxf(fmaxf(zm, s[kk][e]), s[kk][e + 1]);
            zm = fmaxf(zm, s[kk][15]);
            if (!__any(zm > 30.0f)) {
                float tt[16], gs[4], pg[4];
#pragma unroll
                for (int e = 0; e < 16; ++e) { s[kk][e] = __builtin_amdgcn_exp2f(s[kk][e]); tt[e] = 1.0f + s[kk][e]; }
#pragma unroll
                for (int g = 0; g < 4; ++g) { const float p0 = (tt[4 * g] * tt[4 * g + 1]) * (tt[4 * g + 2] * tt[4 * g + 3]); gs[g] = __builtin_amdgcn_logf(p0); pg[g] = xhalf(gs[g], h);
                    tt[4 * g + 3] = __builtin_amdgcn_rcpf(p0); }
#pragma unroll
                for (int g = 3; g >= 0; --g) { const float c = run + (h == 0 ? pg[g] : 0.f); run += gs[g] + pg[g];
                    const float rr = tt[4 * g + 3] * __builtin_amdgcn_exp2f(-c), q1 = tt[4 * g], q2 = q1 * tt[4 * g + 1], q3 = q2 * tt[4 * g + 2];
                    s[kk][4 * g] = s[kk][4 * g] * rr; s[kk][4 * g + 1] = (s[kk][4 * g + 1] * q1) * rr; s[kk][4 * g + 2] = (s[kk][4 * g + 2] * q2) * rr; s[kk][4 * g + 3] = (s[kk][4 * g + 3] * q3) * rr; }
            } else {
                float sp[16];
#pragma unroll
                for (int e = 0; e < 16; ++e) { const float z = s[kk][e]; sp[e] = fmaxf(z, 0.f) + __builtin_amdgcn_logf(1.0f + __builtin_amdgcn_exp2f(-fabsf(z))); }
                float gs[4], pg[4];
#pragma unroll
                for (int g = 0; g < 4; ++g) { gs[g] = (sp[4 * g] + sp[4 * g + 1]) + (sp[4 * g + 2] + sp[4 * g + 3]); pg[g] = xhalf(gs[g], h); }
#pragma unroll
                for (int g = 3; g >= 0; --g) { float c = run + (h == 0 ? pg[g] : 0.f); run += gs[g] + pg[g];
#pragma unroll
                    for (int jj = 3; jj >= 0; --jj) { const int e = 4 * g + jj; c += sp[e]; s[kk][e] = __builtin_amdgcn_exp2f(s[kk][e] - c); } }
            }
            ATT_PACK(s[kk], kk);
            __builtin_amdgcn_sched_barrier(0);
        }
        Rrun = run;
    }
#undef ATT_PACK
    const int li = lane & 15, tq_ = li >> 2, tp = li & 3;
    const unsigned base0 = (unsigned)((4 * h + tq_) * 256 + (tq_ << 6) + (2 * ((lane >> 4) & 1) + (tp >> 1)) * 16 + 8 * (tp & 1));
#pragma unroll
    for (int b = 0; b < 4; ++b)
#pragma unroll
        for (int kk = 0; kk < 2; ++kk)
#pragma unroll
            for (int s2 = 0; s2 < 2; ++s2) { const LAS unsigned char* p = vb + ((base0 ^ (unsigned)(b << 6)) + (unsigned)((32 * kk + 16 * s2) * 256));
                const s16x4 lo = vtr(p), hi = vtr(p + 8 * 256);
                const bf16x8 vf = (bf16x8){lo[0], lo[1], lo[2], lo[3], hi[0], hi[1], hi[2], hi[3]};
                o[b] = __builtin_amdgcn_mfma_f32_32x32x16_bf16(vf, pf[kk][s2], o[b], 0, 0, 0); }
}

template <int DK, int MODE>
__device__ __forceinline__ void attn_unit(LAS unsigned char* lds, const bf16_t* Q, int ldq, const bf16_t* Kp, int ldk, const bf16_t* Vp, int ldv, bf16_t* O, int ldo, int u0, int r4) {
    constexpr int KBYTES = 16384, BUF = 32768, KCH = DK / 8, NB = 4;
    int tid = threadIdx.x; asm volatile("" : "+v"(tid));
    const GAS bf16_t* Qg = (const GAS bf16_t*)Q; GAS bf16_t* Og = (GAS bf16_t*)O;
    const int wave = __builtin_amdgcn_readfirstlane(tid >> 6), lane = tid & 63, r = lane & 31, h = lane >> 5;
    int tq, tqmin, tqmax;
    if (MODE == 0) { tqmin = r4 + 4 * (u0 + 32 * wave); tq = tqmin + 4 * r; tqmax = tqmin + 124; }
    else { tqmin = 256 * u0 + 32 * wave; tq = tqmin + r; tqmax = tqmin + 31; }
    bf16x8 qf[DK / 16];
#pragma unroll
    for (int ks = 0; ks < DK / 16; ++ks) qf[ks] = *(const GAS bf16x8*)(Qg + (size_t)tq * ldq + 16 * ks + 8 * h);
    f32x16 o[4];
#pragma unroll
    for (int b = 0; b < 4; ++b)
#pragma unroll
        for (int e = 0; e < 16; ++e) o[b][e] = 0.f;
    float mrun = -1e30f, lrun = 0.f, Rrun = 0.f;
    const int ntiles = (MODE == 0) ? 36 : 4 * (u0 + 1);
    const int drow = lane >> 4, dpos = lane & 15;
    const int kchunk0 = dpos ^ ((8 * wave + drow) & 15), vchunk = dpos ^ (4 * (drow & 3));
#define ATT_IDX(i) ((MODE == 2) ? (ntiles - 1 - (i)) : (MODE == 0) ? (((i) < 18) ? (((i) >> 1) + 9 * ((i) & 1)) : ((i) < 24) ? (18 + (((i) - 18) >> 1) + 3 * ((i) & 1)) : (i)) : (i))
    const unsigned kvo0 = (unsigned)((8 * wave + drow) * ldk * 2), vvo0 = (unsigned)((8 * wave + drow) * ldv * 2);
    const unsigned kc0b = (unsigned)(kchunk0 * 16), vcb = (unsigned)(vchunk * 16);
#define ATT_DMA(tok0_, st_, buf_) do { LAS unsigned char* kb_ = lds + (buf_) * BUF + wave * 2048; \
        const int sh_ = (MODE != 0 || (st_) == 1) ? 0 : ((st_) == 4 ? 2 : 4); \
        const char* kt_ = (const char*)Kp + (size_t)(tok0_) * ldk * 2; const char* vt_ = (const char*)Vp + (size_t)(tok0_) * ldv * 2; \
        if (kchunk0 < KCH) __builtin_amdgcn_global_load_lds((const unsigned*)(kt_ + ((kvo0 << sh_) + kc0b)), (LAS unsigned*)(kb_), 16, 0, 0); \
        if ((kchunk0 ^ 4) < KCH) __builtin_amdgcn_global_load_lds((const unsigned*)(kt_ + (((kvo0 + (unsigned)(8 * ldk)) << sh_) + (kc0b ^ 64u))), (LAS unsigned*)(kb_ + 1024), 16, 0, 0); \
        __builtin_amdgcn_global_load_lds((const unsigned*)(vt_ + ((vvo0 << sh_) + vcb)), (LAS unsigned*)(kb_ + KBYTES), 16, 0, 0); \
        __builtin_amdgcn_global_load_lds((const unsigned*)(vt_ + (((vvo0 + (unsigned)(8 * ldv)) << sh_) + vcb)), (LAS unsigned*)(kb_ + KBYTES + 1024), 16, 0, 0); } while (0)
#define ATT_KLD(kb, kk, ks) (*(const LAS bf16x8*)((kb) + (32 * (kk) + r) * 256 + (((2 * (ks) + h) ^ (r & 15)) << 4)))
#define ATT_QK2(d0_, d1_, kb) do { _Pragma("unroll") for (int e = 0; e < 16; ++e) { d0_[e] = 0.f; d1_[e] = 0.f; } \
        bf16x8 ka_[2][2]; ka_[0][0] = ATT_KLD(kb, 0, 0); ka_[0][1] = ATT_KLD(kb, 1, 0); ka_[1][0] = ATT_KLD(kb, 0, 1); ka_[1][1] = ATT_KLD(kb, 1, 1); \
        __builtin_amdgcn_sched_barrier(0); \
        _Pragma("unroll") for (int ks = 0; ks < DK / 16; ++ks) { \
            d0_ = __builtin_amdgcn_mfma_f32_32x32x16_bf16(ka_[ks & 1][0], qf[ks], d0_, 0, 0, 0); d1_ = __builtin_amdgcn_mfma_f32_32x32x16_bf16(ka_[ks & 1][1], qf[ks], d1_, 0, 0, 0); \
            __builtin_amdgcn_sched_barrier(0); \
            if (ks + 2 < DK / 16) { ka_[ks & 1][0] = ATT_KLD(kb, 0, ks + 2); ka_[ks & 1][1] = ATT_KLD(kb, 1, ks + 2); } \
            __builtin_amdgcn_sched_barrier(0); } } while (0)
#define ATT_REL(tok0_, st_, dil_) ((MODE == 0) ? (((tok0_) + 63 * (st_) >= tqmin - 128 * (dil_)) && ((tok0_) <= tqmax)) : ((tok0_) <= tqmax))
    const int npairs = ntiles >> 1;
#define ATT_DMAPAIR(p_) do { _Pragma("unroll") for (int s_ = 0; s_ < 2; ++s_) { int tk_, sv_, dv_; tile_desc<MODE>(ATT_IDX(2 * (p_) + s_), u0, r4, tk_, sv_, dv_); \
            if (tk_ >= 0) ATT_DMA(tk_, sv_, 2 * ((p_) & 1) + s_); } } while (0)
    __syncthreads();
    ATT_DMAPAIR(0);
    asm volatile("s_waitcnt vmcnt(0)" ::: "memory");
    __builtin_amdgcn_s_barrier(); asm volatile("" ::: "memory");
    for (int p = 0; p < npairs; ++p) {
        if (p + 1 < npairs) ATT_DMAPAIR(p + 1);
#pragma unroll
        for (int s_ = 0; s_ < 2; ++s_) { int tok0, st, dil; tile_desc<MODE>(ATT_IDX(2 * p + s_), u0, r4, tok0, st, dil);
            const LAS unsigned char* kb = lds + (2 * (p & 1) + s_) * BUF;
            if (tok0 >= 0 && ATT_REL(tok0, st, dil)) { f32x16 s[2]; ATT_QK2(s[0], s[1], kb); att_smpv<MODE>(s, o, mrun, lrun, Rrun, tq, tqmin, tok0, st, dil, h, lane, kb + KBYTES); } }
        asm volatile("s_waitcnt vmcnt(0)" ::: "memory");
        __builtin_amdgcn_s_barrier(); asm volatile("" ::: "memory");
    }
#undef ATT_DMAPAIR
    float sc = 1.0f;
    if (MODE != 2) { const float lt = lrun + xhalf(lrun, h); sc = 1.0f / lt; }
#pragma unroll
    for (int b = 0; b < 4; ++b)
#pragma unroll
        for (int g = 0; g < 4; ++g) { u32x2 w; w.x = cvt_pk_bf16(o[b][4 * g] * sc, o[b][4 * g + 1] * sc); w.y = cvt_pk_bf16(o[b][4 * g + 2] * sc, o[b][4 * g + 3] * sc);
            *(GAS u32x2*)(Og + (size_t)tq * ldo + 32 * b + 8 * g + 4 * h) = w; }
#undef ATT_IDX
#undef ATT_DMA
#undef ATT_KLD
#undef ATT_QK2
#undef ATT_REL
}

template <int W>
__device__ __forceinline__ bf16x8 pool_frag(const GAS bf16_t* up, int cnt, float icnt) {
    u32x4 v[W];
#pragma unroll
    for (int j = 0; j < W; ++j) v[j] = *(const GAS u32x4*)(up - (size_t)(j < cnt ? j : 0) * INO);
    float sum[8];
#pragma unroll
    for (int e = 0; e < 8; ++e) sum[e] = 0.f;
#pragma unroll
    for (int j = 0; j < W; ++j) { const float m = j < cnt ? 1.0f : 0.0f;
        sum[0] += m * bf_lo(v[j].x); sum[1] += m * bf_hi(v[j].x); sum[2] += m * bf_lo(v[j].y); sum[3] += m * bf_hi(v[j].y);
        sum[4] += m * bf_lo(v[j].z); sum[5] += m * bf_hi(v[j].z); sum[6] += m * bf_lo(v[j].w); sum[7] += m * bf_hi(v[j].w); }
    const u32x4 self = v[0]; float o[8];
    o[0] = sum[0] * icnt - bf_lo(self.x); o[1] = sum[1] * icnt - bf_hi(self.x); o[2] = sum[2] * icnt - bf_lo(self.y); o[3] = sum[3] * icnt - bf_hi(self.y);
    o[4] = sum[4] * icnt - bf_lo(self.z); o[5] = sum[5] * icnt - bf_hi(self.z); o[6] = sum[6] * icnt - bf_lo(self.w); o[7] = sum[7] * icnt - bf_hi(self.w);
    return __builtin_bit_cast(bf16x8, pack8(o));
}
__device__ __forceinline__ void pool_unit(const bf16_t* proj, const bf16_t* pw, const float* scale, bf16_t* mrg, int wu, int lane) {
    const int g = (wu + (wu >> 11)) & 3, rb = wu >> 2, fr = lane & 15, fq = lane >> 4;
    const int row = rb * 16 + fr, t = row & (SEQ - 1), w = 2 << g;
    const int cnt = (t + 1 < w) ? (t + 1) : w; const float icnt = 1.0f / (float)cnt;
    bf16x8 pfr[4];
#pragma unroll
    for (int ks = 0; ks < 4; ++ks) { const GAS bf16_t* up = (const GAS bf16_t*)proj + (size_t)row * INO + g * 128 + 32 * ks + 8 * fq;
        if (g == 0) pfr[ks] = pool_frag<2>(up, cnt, icnt); else if (g == 1) pfr[ks] = pool_frag<4>(up, cnt, icnt); else if (g == 2) pfr[ks] = pool_frag<8>(up, cnt, icnt); else pfr[ks] = pool_frag<16>(up, cnt, icnt); }
#pragma unroll
    for (int nt = 0; nt < 8; ++nt) { f32x4 acc = (f32x4){0.f, 0.f, 0.f, 0.f};
#pragma unroll
        for (int ks = 0; ks < 4; ++ks) { const bf16x8 wf = *(const GAS bf16x8*)((const GAS bf16_t*)pw + (size_t)(g * 128 + 16 * nt + fr) * 128 + 32 * ks + 8 * fq);
            acc = __builtin_amdgcn_mfma_f32_16x16x32_bf16(wf, pfr[ks], acc, 0, 0, 0); }
        const int e0 = g * 128 + 16 * nt + 4 * fq; const f32x4 sc = *(const GAS f32x4*)((const GAS float*)scale + e0);
        u32x2 wv; wv.x = cvt_pk_bf16(acc[0] * sc[0], acc[1] * sc[1]); wv.y = cvt_pk_bf16(acc[2] * sc[2], acc[3] * sc[3]);
        *(GAS u32x2*)((GAS bf16_t*)mrg + (size_t)row * DMO + e0) = wv; }
}

__device__ __forceinline__ int map_row(int mode, int n) {
    if (mode == 1) return (n >> 7) * 256 + (n & 127);
    if (mode == 2) return (n >> 7) * 256 + 128 + (n & 127);
    if (mode == 3) {
        if (n < 1536) { const int d = n & 127, nb = d >> 6, low = d & 63; return (n & ~127) + ((low >> 4) << 5) + (((low >> 2) & 3) << 3) + (nb << 2) + (low & 3); }
        if (n >= 2944) { const int d = n - 2944, nb = d >> 4, low = d & 15; return 2944 + ((low >> 2) << 3) + (nb << 2) + (low & 3); }
        return n;
    }
    if (mode == 4) { const int hd = n / 96; int d = n - hd * 96; if (d < 64) return n; d -= 64; const int nb = d >> 4, low = d & 15; return hd * 96 + 64 + ((low >> 2) << 3) + (nb << 2) + (low & 3); }
    return n;
}
struct TItem { const float* W; const float* gain; bf16_t* WT; int K, N, mode, item; };
__device__ __forceinline__ void titem_load(const TItem& t, float (&rg)[32], int lane) {
    const int nblk = t.N / 32, kb = t.item / nblk, nb = t.item - kb * nblk, k0 = 64 * kb, n0 = 32 * nb;
#pragma unroll
    for (int i = 0; i < 32; ++i) { const int kk = 2 * i + (lane >> 5); const float gg = t.gain ? ((const GAS float*)t.gain)[k0 + kk] : 1.0f; rg[i] = ((const GAS float*)t.W)[(size_t)(k0 + kk) * t.N + n0 + (lane & 31)] * gg; }
}
__device__ __forceinline__ void titem_finish(const TItem& t, const float (&rg)[32], LAS float* scr, int lane) {
    const int nblk = t.N / 32, kb = t.item / nblk, nb = t.item - kb * nblk, k0 = 64 * kb, n0 = 32 * nb;
#pragma unroll
    for (int i = 0; i < 32; ++i) { const int kk = 2 * i + (lane >> 5); scr[kk * 33 + (lane & 31)] = rg[i]; }
    asm volatile("s_waitcnt lgkmcnt(0)" ::: "memory");
    const int c = lane & 7;
#pragma unroll
    for (int j = 0; j < 4; ++j) { const int n = (lane >> 3) + 8 * j; const LAS float* sp = scr + (8 * c) * 33 + n;
        u32x4 o; o.x = cvt_pk_bf16(sp[0 * 33], sp[1 * 33]); o.y = cvt_pk_bf16(sp[2 * 33], sp[3 * 33]); o.z = cvt_pk_bf16(sp[4 * 33], sp[5 * 33]); o.w = cvt_pk_bf16(sp[6 * 33], sp[7 * 33]);
        *(GAS u32x4*)((GAS bf16_t*)t.WT + (size_t)map_row(t.mode, n0 + n) * t.K + k0 + 8 * c) = o; }
    asm volatile("s_waitcnt lgkmcnt(0)" ::: "memory");
}

struct Args { const float* in[17]; float* out; unsigned char* ws; int lo, hi; };
typedef const __attribute__((address_space(4))) Args* ArgsP;

__device__ __forceinline__ void prologue(ArgsP ap, unsigned char* ws, LAS unsigned char* lds, int gw, int ngw, int wave, int lane) {
    LAS float* scr = (LAS float*)(lds + wave * 16384);
    const float* ng = ap->in[2];
    constexpr int I_GU = 32 * 48, I_DN = 24 * 64, I_INE = 32 * 93, I_INO = 32 * 64, I_QUP = 6 * 12, I_KVUP = 4 * 24, I_OUTE = 20 * 64, I_OUTO = 16 * 64, I_POOL = 2 * 4;
    constexpr int NITEMS = 8 * I_GU + 4 * I_DN + I_INE + I_INO + I_QUP + I_KVUP + I_OUTE + I_OUTO + 4 * I_POOL;
    auto decode = [&](int it) -> TItem {
        TItem t; int r = it;
        if (r < 8 * I_GU) { const int w = r / I_GU, f = w >> 1, up = w & 1; r -= w * I_GU;
            t.W = (up ? ap->in[4] : ap->in[3]) + (size_t)f * D * FF; t.gain = ng + (size_t)((f >> 1) * 3 + ((f & 1) ? 2 : 0)) * D;
            t.WT = (bf16_t*)(ws + WS_WGU) + (size_t)f * 3072 * D; t.K = D; t.N = FF; t.mode = up ? 2 : 1; t.item = r; return t; }
        r -= 8 * I_GU;
        if (r < 4 * I_DN) { const int f = r / I_DN; r -= f * I_DN; t.W = ap->in[5] + (size_t)f * FF * D; t.gain = nullptr; t.WT = (bf16_t*)(ws + WS_WD) + (size_t)f * D * FF; t.K = FF; t.N = D; t.mode = 0; t.item = r; return t; }
        r -= 4 * I_DN;
        if (r < I_INE) { t.W = ap->in[6]; t.gain = ng + 1 * D; t.WT = (bf16_t*)(ws + WS_WINE); t.K = D; t.N = 2976; t.mode = 3; t.item = r; return t; } r -= I_INE;
        if (r < I_INO) { t.W = ap->in[12]; t.gain = ng + 4 * D; t.WT = (bf16_t*)(ws + WS_WINO); t.K = D; t.N = INO; t.mode = 0; t.item = r; return t; } r -= I_INO;
        if (r < I_QUP) { t.W = ap->in[8]; t.gain = ap->in[7]; t.WT = (bf16_t*)(ws + WS_WQUP); t.K = 384; t.N = 384; t.mode = 4; t.item = r; return t; } r -= I_QUP;
        if (r < I_KVUP) { t.W = ap->in[10]; t.gain = ap->in[9]; t.WT = (bf16_t*)(ws + WS_WKVUP); t.K = 256; t.N = 768; t.mode = 0; t.item = r; return t; } r -= I_KVUP;
        if (r < I_OUTE) { t.W = ap->in[11]; t.gain = nullptr; t.WT = (bf16_t*)(ws + WS_WOUTE); t.K = DME; t.N = D; t.mode = 0; t.item = r; return t; } r -= I_OUTE;
        if (r < I_OUTO) { t.W = ap->in[15]; t.gain = nullptr; t.WT = (bf16_t*)(ws + WS_WOUTO); t.K = DMO; t.N = D; t.mode = 0; t.item = r; return t; } r -= I_OUTO;
        { const int g = r / I_POOL; r -= g * I_POOL; t.W = ap->in[13] + (size_t)g * 128 * 128; t.gain = nullptr; t.WT = (bf16_t*)(ws + WS_POOLW) + (size_t)g * 128 * 128; t.K = 128; t.N = 128; t.mode = 0; t.item = r; return t; }
    };
    for (int it = gw; it < NITEMS; it += 2 * ngw) {
        const bool hasB = it + ngw < NITEMS;
        const TItem A = decode(it), B = decode(hasB ? it + ngw : it);
        float ra[32], rb[32];
        titem_load(A, ra, lane); titem_load(B, rb, lane);
        titem_finish(A, ra, scr, lane);
        if (hasB) titem_finish(B, rb, scr, lane);
    }
    { u32x4* z = (u32x4*)((bf16_t*)(ws + WS_WINE) + (size_t)2976 * D); const int n = 96 * D / 8; for (int i = gw * 64 + lane; i < n; i += ngw * 64) z[i] = (u32x4){0u, 0u, 0u, 0u};
      u32x4* z2 = (u32x4*)((bf16_t*)(ws + WS_WQUP) + (size_t)384 * 384); const int n2 = 128 * 384 / 8; for (int i = gw * 64 + lane; i < n2; i += ngw * 64) z2[i] = (u32x4){0u, 0u, 0u, 0u}; }
    const float* x = ap->in[0]; bf16_t* hb = (bf16_t*)(ws + WS_HB); float* ssq = (float*)(ws + WS_SSQ);
    for (int m0 = gw; m0 < M; m0 += 4 * ngw) {
        f32x4 v[4][8]; int mr[4]; bool ok[4];
#pragma unroll
        for (int q = 0; q < 4; ++q) { ok[q] = m0 + q * ngw < M; mr[q] = ok[q] ? m0 + q * ngw : m0; const GAS f32x4* xr = (const GAS f32x4*)((const GAS float*)x + (size_t)mr[q] * D) + lane;
#pragma unroll
            for (int j = 0; j < 8; ++j) v[q][j] = __builtin_nontemporal_load(xr + 64 * j); }
#pragma unroll
        for (int q = 0; q < 4; ++q) { GAS u32x2* o8 = (GAS u32x2*)((GAS bf16_t*)hb + (size_t)mr[q] * D) + lane; float sq = 0.f;
#pragma unroll
            for (int j = 0; j < 8; ++j) { const f32x4 w = v[q][j]; sq += (w.x * w.x + w.y * w.y) + (w.z * w.z + w.w * w.w);
                if (ok[q]) { u32x2 p; p.x = cvt_pk_bf16(w.x, w.y); p.y = cvt_pk_bf16(w.z, w.w); o8[64 * j] = p; } }
            sq = wave_sum(sq);
            if (ok[q] && lane < 32) ((GAS float*)ssq)[(size_t)mr[q] * 32 + lane] = lane == 0 ? sq : 0.f; } }
}

__device__ __forceinline__ void fast_grid_barrier(unsigned* bar, unsigned epoch, volatile LAS unsigned* bst) {
    __syncthreads();
    if (threadIdx.x == 0) {
        const unsigned xcc = bst[0], nx = bst[1], nxcd = bst[2];
        const unsigned old = __hip_atomic_fetch_add(bar + 64u * (1u + xcc), 1u, __ATOMIC_RELAXED, __HIP_MEMORY_SCOPE_AGENT);
        if (old + 1u == epoch * nx) { __builtin_amdgcn_fence(__ATOMIC_RELEASE, "agent"); __hip_atomic_fetch_add(bar, 1u, __ATOMIC_RELAXED, __HIP_MEMORY_SCOPE_AGENT); }
        while (__hip_atomic_load(bar, __ATOMIC_RELAXED, __HIP_MEMORY_SCOPE_AGENT) < epoch * nxcd) __builtin_amdgcn_s_sleep(1);
        __builtin_amdgcn_fence(__ATOMIC_ACQUIRE, "agent");
    }
    __syncthreads();
}

constexpr int LDS_BYTES = 147456;
constexpr int NSTEPS = 17 + (DUPSTEP >= 0 ? 1 : 0);

__global__ void __launch_bounds__(512, 2) mega(Args a) {
    extern __shared__ __attribute__((aligned(16))) unsigned char lds_raw[];
    LAS unsigned char* lds = (LAS unsigned char*)lds_raw;
    cg::grid_group grid = cg::this_grid();
    const int tid = threadIdx.x, lane0 = tid & 63, wave0 = __builtin_amdgcn_readfirstlane(tid >> 6);

    unsigned epoch = 0;
    volatile LAS unsigned* bst = (volatile LAS unsigned*)(lds + 139264);
    if (threadIdx.x == 0) { const unsigned xcc = (unsigned)__builtin_amdgcn_s_getreg((3 << 11) | 20) & 0xFu;
        bst[0] = xcc; __hip_atomic_fetch_add((unsigned*)(a.ws + WS_BAR) + 64u * (17u + xcc), 1u, __ATOMIC_RELAXED, __HIP_MEMORY_SCOPE_AGENT); }
    for (int step = a.lo; step < a.hi; ++step) {
        if (step > a.lo) {
            if (step == a.lo + 1) {
                grid.sync();
                if (threadIdx.x == 0) {
                    unsigned* bar = (unsigned*)(a.ws + WS_BAR); unsigned nxcd = 0;
                    for (unsigned x = 0; x < 16; ++x) nxcd += __hip_atomic_load(bar + 64u * (17u + x), __ATOMIC_RELAXED, __HIP_MEMORY_SCOPE_AGENT) != 0u;
                    bst[1] = __hip_atomic_load(bar + 64u * (17u + bst[0]), __ATOMIC_RELAXED, __HIP_MEMORY_SCOPE_AGENT); bst[2] = nxcd;
                }
            } else { ++epoch; fast_grid_barrier((unsigned*)(a.ws + WS_BAR), epoch, bst); }
        }
        int lane = lane0; asm volatile("" : "+v"(lane));
        ArgsP ap = (ArgsP)__builtin_amdgcn_kernarg_segment_ptr(); asm volatile("" : "+s"(ap));
        int wave = wave0, G = gridDim.x, bx = blockIdx.x; unsigned char* ws = ap->ws;
        asm volatile("" : "+s"(wave), "+s"(G), "+s"(bx), "+s"(ws));
        const int vcu = (G % 8 == 0) ? (bx % 8) * (G / 8) + bx / 8 : bx;
        const int gw = vcu * 8 + wave, ngw = G * 8;
        bf16_t* hb = (bf16_t*)(ws + WS_HB); bf16_t* act = (bf16_t*)(ws + WS_ACT); bf16_t* proj = (bf16_t*)(ws + WS_PROJ);
        bf16_t* qfb = (bf16_t*)(ws + WS_QF); bf16_t* kfb = (bf16_t*)(ws + WS_KF); bf16_t* vbb = (bf16_t*)(ws + WS_VB); bf16_t* mrg = (bf16_t*)(ws + WS_MRG);
        float* ssq = (float*)(ws + WS_SSQ); float* ste = (float*)(ws + WS_STE);
        const int* pos = (const int*)ap->in[1];
        float* hres = ap->out;
        const int kind = (DUPSTEP >= 0 && step > DUPSTEP) ? step - 1 : step;
        if (kind == 0 && PON(0)) { prologue(ap, ws, lds, gw, ngw, wave, lane); __syncthreads(); }
        else if (PON(1) && (kind == 1 || kind == 7 || kind == 9 || kind == 14)) {
            const int f = kind == 1 ? 0 : kind == 7 ? 1 : kind == 9 ? 2 : 3;
            pg8::Gemm g{hb, (const bf16_t*)(ws + WS_WGU) + (size_t)f * 3072 * D, M, 3072, D, D, D}; pg8::StaticOrder S; S.init(M, 3072, G, bx);
            EpiSwiglu E{ssq, act}; pg8::gemm_phase(lds, g, S, E);
        } else if (PON(2) && (kind == 2 || kind == 8 || kind == 10 || kind == 15 || kind == 6 || kind == 13)) {
            pg8::Gemm g; float coef;
            if (kind == 6) { g = pg8::Gemm{mrg, (const bf16_t*)(ws + WS_WOUTE), M, D, DME, DME, DME}; coef = 1.0f; }
            else if (kind == 13) { g = pg8::Gemm{mrg, (const bf16_t*)(ws + WS_WOUTO), M, D, DMO, DMO, DMO}; coef = 1.0f; }
            else { const int f = kind == 2 ? 0 : kind == 8 ? 1 : kind == 10 ? 2 : 3; g = pg8::Gemm{act, (const bf16_t*)(ws + WS_WD) + (size_t)f * D * FF, M, D, FF, FF, FF}; coef = 0.5f; }
            pg8::StaticOrder S; S.init(M, D, G, bx);
            EpiResid E{hb, ssq, coef}; pg8::gemm_phase(lds, g, S, E);
        } else if (PON(3) && kind == 3) {
            pg8::Gemm g{hb, (const bf16_t*)(ws + WS_WINE), M, INE, D, D, D}; pg8::StaticOrder S; S.init(M, INE, G, bx);
            EpiInEven E{ssq, pos, proj, ste, kfb}; pg8::gemm_phase(lds, g, S, E);
        } else if (PON(4) && kind == 4) {
#ifndef NO_QUP
            { pg8::Gemm g{proj + 2304, (const bf16_t*)(ws + WS_WQUP), M, 512, 384, INE, 384}; pg8::StaticOrder S; S.init(M, 512, G, bx);
              EpiQup E{ste, pos, qfb}; pg8::gemm_phase(lds, g, S, E); }
#endif
#ifndef NO_KVUP
            { pg8::Gemm g{proj + 2688, (const bf16_t*)(ws + WS_WKVUP), M, 768, 256, INE, 256}; pg8::StaticOrder S; S.init(M, 768, G, bx);
              EpiKvup E{ste, kfb, vbb}; pg8::gemm_phase(lds, g, S, E); }
#endif
        } else if (PON(5) && kind == 5) {
            {
            for (int pi = vcu; pi < 256; pi += G) { const int bh = pi >> 5, x = pi & 31, b = bh >> 2, hd = bh & 3; const size_t ro = (size_t)b * SEQ;
                for (int k = 0; k < 2; ++k) { const int qb = k == 0 ? 63 - x : x;
                    attn_unit<96, 1>(lds, qfb + ro * 384 + hd * 96, 384, kfb + ro * 384 + hd * 96, 384, vbb + ro * 512 + hd * 128, 512, mrg + ro * DME + 768 + hd * 128, DME, qb, 0); } }
            for (int ui = vcu; ui < 768; ui += G) { const int pb = ui & 15, r4 = (ui >> 4) & 3, hb6 = ui >> 6, hd = hb6 % 6, b = hb6 / 6; const size_t ro = (size_t)b * SEQ;
                attn_unit<128, 0>(lds, proj + ro * INE + hd * 128, INE, proj + ro * INE + 768 + hd * 128, INE, proj + ro * INE + 1536 + hd * 128, INE, mrg + ro * DME + hd * 128, DME, pb * 256, r4); }
            }
        } else if (PON(11) && kind == 11) {
            pg8::Gemm g{hb, (const bf16_t*)(ws + WS_WINO), M, INO, D, D, D}; pg8::StaticOrder S; S.init(M, INO, G, bx);
            EpiInOdd E{ssq, proj}; pg8::gemm_phase(lds, g, S, E);
        } else if (PON(12) && kind == 12) {
            {
            for (int pi = vcu; pi < 256; pi += G) { const int bh = pi >> 5, x = pi & 31, b = bh >> 2, hd = bh & 3; const size_t ro = (size_t)b * SEQ;
                for (int k = 0; k < 2; ++k) { const int qb = k == 0 ? 63 - x : x;
                    attn_unit<128, 2>(lds, proj + ro * INO + 512 + hd * 128, INO, proj + ro * INO + 1024 + hd * 128, INO, proj + ro * INO + 1536 + hd * 128, INO, mrg + ro * DMO + 512 + hd * 128, DMO, qb, 0); } }
            for (int wu = gw; wu < (M / 16) * 4; wu += ngw) pool_unit(proj, (const bf16_t*)(ws + WS_POOLW), ap->in[14], mrg, wu, lane);
            }
        } else if (PON(16) && kind == 16) {
            const float* gf = ap->in[16];
            const GAS f32x4* gr = (const GAS f32x4*)(const GAS float*)gf + lane;
            for (int m0 = gw; m0 < M; m0 += 8 * ngw) {
                u32x2 v[8][8]; float sq[8]; int mr[8]; bool ok[8];
#pragma unroll
                for (int q = 0; q < 8; ++q) { ok[q] = m0 + q * ngw < M; mr[q] = ok[q] ? m0 + q * ngw : m0;
                    sq[q] = lane < 32 ? ((const GAS float*)ssq)[(size_t)mr[q] * 32 + lane] : 0.f;
                    const GAS u32x2* br = (const GAS u32x2*)((const GAS bf16_t*)hb + (size_t)mr[q] * D) + lane;
#pragma unroll
                    for (int j = 0; j < 8; ++j) v[q][j] = br[64 * j]; }
#pragma unroll
                for (int q = 0; q < 8; ++q) { const float rq = 1.0f / sqrtf(wave_sum(sq[q]) * (1.0f / D) + EPS);
                    GAS f32x4* xr = (GAS f32x4*)((GAS float*)hres + (size_t)mr[q] * D) + lane;
#pragma unroll
                    for (int j = 0; j < 8; ++j) { const f32x4 gg = gr[64 * j]; const f32x4 a = (f32x4){bf_lo(v[q][j].x), bf_hi(v[q][j].x), bf_lo(v[q][j].y), bf_hi(v[q][j].y)};
                        if (ok[q]) __builtin_nontemporal_store(a * rq * gg, xr + 64 * j); } } }
        }
    }
}

extern "C" void kernel_launch(void* const* d_in, const int* in_sizes, int n_in, void* d_out, int out_size, void* d_ws, size_t ws_size, hipStream_t stream) {
    static int grid = 0;
    if (grid == 0) {
        if (n_in != 17 || out_size != M * D || ws_size < WS_END) { fprintf(stderr, "kernel_launch: unexpected shapes (n_in %d out %d ws %zu need %zu)\n", n_in, out_size, ws_size, (size_t)WS_END); grid = -1; return; }
        int dev = 0, cus = 0, per_cu = 0;
        hipGetDevice(&dev); hipDeviceGetAttribute(&cus, hipDeviceAttributeMultiprocessorCount, dev);
        if (hipFuncSetAttribute((const void*)mega, hipFuncAttributeMaxDynamicSharedMemorySize, LDS_BYTES) != hipSuccess) { fprintf(stderr, "kernel_launch: hipFuncSetAttribute failed\n"); grid = -1; return; }
        if (hipOccupancyMaxActiveBlocksPerMultiprocessor(&per_cu, (const void*)mega, 512, LDS_BYTES) != hipSuccess || per_cu < 1) { fprintf(stderr, "kernel_launch: occupancy query says %d blocks per CU\n", per_cu); per_cu = 1; }
        (void)hipGetLastError();
        grid = cus * per_cu;
        fprintf(stderr, "kernel_launch: grid %d (cus %d x %d)\n", grid, cus, per_cu);
    }
    if (grid < 0) return;
    Args a{};
    for (int i = 0; i < 17; ++i) a.in[i] = (const float*)d_in[i];
    a.out = (float*)d_out; a.ws = (unsigned char*)d_ws;
    if (hipMemsetAsync((unsigned char*)d_ws + WS_BAR, 0, 16384, stream) != hipSuccess) { fprintf(stderr, "kernel_launch: memset of the barrier word failed\n"); return; }
#if ONE_LAUNCH
    a.lo = 0; a.hi = NSTEPS;
    void* args[] = {&a};
    hipError_t e = hipLaunchCooperativeKernel((const void*)mega, dim3(grid), dim3(512), args, LDS_BYTES, stream);
    if (e != hipSuccess) fprintf(stderr, "kernel_launch: cooperative launch failed: %s (grid %d)\n", hipGetErrorString(e), grid);
#else
    for (int s = 0; s < NSTEPS; ++s) { a.lo = s; a.hi = s + 1; hipLaunchKernelGGL(mega, dim3(grid), dim3(512), LDS_BYTES, stream, a); }
#endif
}
```

```cpp
#include <hip/hip_runtime.h>
#include <hip/hip_cooperative_groups.h>
#include <cstdio>
#include <cstdint>
namespace cg = cooperative_groups;

#ifndef PMASK
#define PMASK 0x1ffff
#endif
#define PON(k) ((PMASK >> (k)) & 1)
#ifndef DUPSTEP
#define DUPSTEP -1
#endif
#ifndef REP5
#define REP5 1
#endif
#ifndef REP12
#define REP12 1
#endif
#ifndef ONE_LAUNCH
#define ONE_LAUNCH 1
#endif

#define LAS __attribute__((address_space(3)))
#define GAS __attribute__((address_space(1)))
typedef unsigned short bf16_t;
typedef short bf16x8 __attribute__((ext_vector_type(8)));
typedef short s16x4 __attribute__((ext_vector_type(4)));
typedef float f32x4 __attribute__((ext_vector_type(4)));
typedef float f32x2 __attribute__((ext_vector_type(2)));
typedef float f32x16 __attribute__((ext_vector_type(16)));
typedef unsigned u32x4 __attribute__((ext_vector_type(4)));
typedef unsigned u32x2 __attribute__((ext_vector_type(2)));
typedef __bf16 bf16x2_t __attribute__((ext_vector_type(2)));

constexpr int SEQ = 16384, NB = 2, M = NB * SEQ, D = 2048, FF = 1536;
constexpr int INE = 3072  , INO = 2048, DME = 1280, DMO = 1024;
constexpr float EPS = 1e-6f;
constexpr float LOG2E = 1.4426950408889634f, LN2 = 0.6931471805599453f;
constexpr float L2THETA = 13.287712379549449f;
constexpr float QSCALE_A = 0.08838834764831845f * LOG2E;
constexpr float QSCALE_B = 0.10206207261596577f * LOG2E;
constexpr float QSCALE_D = 0.08838834764831845f * LOG2E;

constexpr size_t MiB = 1u << 20;
constexpr size_t WS_WGU = 0;
constexpr size_t WS_WD = WS_WGU + 48 * MiB;
constexpr size_t WS_WINE = WS_WD + 24 * MiB;
constexpr size_t WS_WINO = WS_WINE + 12 * MiB;
constexpr size_t WS_WQUP = WS_WINO + 8 * MiB;
constexpr size_t WS_WKVUP = WS_WQUP + 1 * MiB;
constexpr size_t WS_WOUTE = WS_WKVUP + 1 * MiB;
constexpr size_t WS_WOUTO = WS_WOUTE + 5 * MiB;
constexpr size_t WS_POOLW = WS_WOUTO + 4 * MiB;
constexpr size_t WS_HB = WS_POOLW + 1 * MiB;
constexpr size_t WS_ACT = WS_HB + 128 * MiB;
constexpr size_t WS_PROJ = WS_ACT + 96 * MiB;
constexpr size_t WS_QF = WS_PROJ + 192 * MiB;
constexpr size_t WS_KF = WS_QF + 24 * MiB;
constexpr size_t WS_VB = WS_KF + 24 * MiB;
constexpr size_t WS_MRG = WS_VB + 32 * MiB;
constexpr size_t WS_SSQ = WS_MRG + 80 * MiB;
constexpr size_t WS_STE = WS_SSQ + 4 * MiB;
constexpr size_t WS_BAR = WS_STE + 3 * MiB;
constexpr size_t WS_END = WS_BAR + 1 * MiB;

__device__ __forceinline__ unsigned cvt_pk_bf16(float lo, float hi) { unsigned r; asm volatile("v_cvt_pk_bf16_f32 %0, %1, %2" : "=v"(r) : "v"(lo), "v"(hi)); return r; }
__device__ __forceinline__ float bf_lo(unsigned u) { return __builtin_bit_cast(float, u << 16); }
__device__ __forceinline__ float bf_hi(unsigned u) { return __builtin_bit_cast(float, u & 0xffff0000u); }
__device__ __forceinline__ u32x4 pack8(const float* v) { u32x4 w; w.x = cvt_pk_bf16(v[0], v[1]); w.y = cvt_pk_bf16(v[2], v[3]); w.z = cvt_pk_bf16(v[4], v[5]); w.w = cvt_pk_bf16(v[6], v[7]); return w; }
__device__ __forceinline__ float wave_sum(float v) {
#pragma unroll
    for (int o = 1; o < 64; o <<= 1) v += __shfl_xor(v, o);
    return v;
}
__device__ __forceinline__ void sincos_rev(float ang, float& s, float& c) {
    const float chi = 0.15915494309189535f, clo = -1.7182170e-9f * 0.0f + (float)(0.15915494309189535 - (double)0.15915494309189535f);
    const float rh = ang * chi; const float err = __builtin_fmaf(ang, chi, -rh) + ang * clo;
    float fr = (rh - __builtin_floorf(rh)) + err;
    s = __builtin_amdgcn_sinf(fr); c = __builtin_amdgcn_cosf(fr);
}

namespace pg8 {
constexpr int BM = 256, BK = 64, HALF = 128, HTB = HALF * BK * 2, STAGE_BYTES = 8 * HTB, NXCD = 8, WGM = 4;
__host__ __device__ __forceinline__ int lds_byte(int r, int c) { const int st = (r >> 4) * 2 + (c >> 5), rr = r & 15, cc = c & 31, ob = rr * 64 + cc * 2; return st * 1024 + (ob ^ (((ob >> 9) & 1) << 5)); }
__host__ __device__ __forceinline__ void stage_rc(int b, int& R, int& C) { const int st = b / 1024, sb = b % 1024, swz = sb ^ (((sb >> 9) & 1) << 5); R = (st >> 1) * 16 + swz / 64; C = (st & 1) * 32 + (swz % 64) / 2; }
__host__ __device__ __forceinline__ int perm32(int rho) { const int n = rho >> 4, i = rho & 15; return 8 * (i >> 2) + 4 * n + (i & 3); }

struct Unit { int pm, pn; };
struct Gemm { const bf16_t* A; const bf16_t* Bt; int M, N, K, lda, ldb; };

struct StaticOrder {
    int nM, nN, nwg, G, c;
    __host__ __device__ void init(int M_, int N_, int G_, int c_) { nM = M_ / BM; nN = N_ / BM; nwg = nM * nN; G = G_; c = c_; }
    __host__ __device__ bool next(int i, Unit& u) const {
        const long L = (long)i * G + c; if (L >= nwg) return false;
        int wgid = (int)L; { const int q = nwg / NXCD, r = nwg % NXCD, xcd = wgid % NXCD, off = wgid / NXCD; wgid = (xcd < r ? xcd * (q + 1) : r * (q + 1) + (xcd - r) * q) + off; }
        const int nig = WGM * nN, gid = wgid / nig, fm = gid * WGM, gsz = (nM - fm) < WGM ? (nM - fm) : WGM;
        u.pm = fm + ((wgid % nig) % gsz); u.pn = (wgid % nig) / gsz; return true;
    }
};

template <class Epi>
__device__ __forceinline__ void gemm_phase(LAS unsigned char* lds, const Gemm g, const StaticOrder& S, const Epi& E) {
    int tid = threadIdx.x; asm volatile("" : "+v"(tid));
    const int wid = __builtin_amdgcn_readfirstlane(tid >> 6), lane = tid & 63, wr = wid >> 2, wc = wid & 3, fr = lane & 15, fq = lane >> 4;
    int K = g.K; asm volatile("" : "+s"(K));
    const int nt = K / BK;
    unsigned voffA[2], voffB[2];
#pragma unroll
    for (int i = 0; i < 2; ++i) { int R, C; stage_rc(tid * 16 + i * 8192, R, C); const int Rb = (R & ~31) + perm32(R & 31);
        voffA[i] = (unsigned)(R * g.lda + C) * 2u; voffB[i] = (unsigned)(Rb * g.ldb + C) * 2u; }
    const size_t kstep = (size_t)(BK * 2);
    const size_t hstepA = (size_t)HALF * g.lda * 2, hstepB = (size_t)HALF * g.ldb * 2;
    const size_t tstepA = 2 * hstepA, tstepB = 2 * hstepB;
    const unsigned ldsw = (unsigned)wid * 1024u;
    const int aoff = lds_byte(wr * 64 + fr, fq * 8), boff = lds_byte(wc * 32 + fr, fq * 8);
#define PG8_SA(b, h) (((b) * 2 + (h)) * HTB)
#define PG8_SB(b, h) ((4 + (b) * 2 + (h)) * HTB)
#define PG8_STAGE(bufoff, gbase, voff) do { _Pragma("unroll") for (int _i = 0; _i < 2; ++_i) \
        __builtin_amdgcn_global_load_lds((const unsigned*)((const char*)(gbase) + (voff)[_i]), (LAS unsigned*)(lds + (bufoff) + ldsw + _i * 8192), 16, 0, 0); } while (0)
#define PG8_LDA(dst, b, h) do { _Pragma("unroll") for (int m = 0; m < 4; ++m) _Pragma("unroll") for (int k = 0; k < 2; ++k) dst[m][k] = *(const LAS bf16x8*)(lds + PG8_SA(b, h) + aoff + m * 2048 + k * 1024); } while (0)
#define PG8_LDB(dst, b, h) do { _Pragma("unroll") for (int n = 0; n < 2; ++n) _Pragma("unroll") for (int k = 0; k < 2; ++k) dst[n][k] = *(const LAS bf16x8*)(lds + PG8_SB(b, h) + boff + n * 2048 + k * 1024); } while (0)
#define PG8_MMA(ai, bj, At, Bt) do { __builtin_amdgcn_s_setprio(1); _Pragma("unroll") for (int m = 0; m < 4; ++m) _Pragma("unroll") for (int n = 0; n < 2; ++n) _Pragma("unroll") for (int k = 0; k < 2; ++k) \
        acc[ai][bj][m][n] = __builtin_amdgcn_mfma_f32_16x16x32_bf16(Bt[n][k], At[m][k], acc[ai][bj][m][n], 0, 0, 0); __builtin_amdgcn_s_setprio(0); } while (0)
#define PG8_WAIT_V(n) asm volatile("s_waitcnt vmcnt(" #n ")" ::: "memory")
#define PG8_WAIT_L(n) asm volatile("s_waitcnt lgkmcnt(" #n ")" ::: "memory")
#define PG8_BAR __builtin_amdgcn_s_barrier()
#define PG8_SCHED __builtin_amdgcn_sched_barrier(0)
    Unit cur, nxt; int ui = 0;
    if (!S.next(0, cur)) return;
    f32x4 acc[2][2][4][2];
#pragma unroll
    for (int a = 0; a < 2; ++a)
#pragma unroll
        for (int b = 0; b < 2; ++b)
#pragma unroll
            for (int m = 0; m < 4; ++m)
#pragma unroll
                for (int n = 0; n < 2; ++n) acc[a][b][m][n] = (f32x4){0.f, 0.f, 0.f, 0.f};
    bf16x8 At[4][2], B0[2][2], B1[2][2];
    const char* cA = (const char*)g.A + (size_t)cur.pm * tstepA; const char* cB = (const char*)g.Bt + (size_t)cur.pn * tstepB;
    PG8_STAGE(PG8_SB(0, 0), cB, voffB); PG8_STAGE(PG8_SB(0, 1), cB + hstepB, voffB); PG8_STAGE(PG8_SA(0, 0), cA, voffA); PG8_STAGE(PG8_SA(0, 1), cA + hstepA, voffA);
    if (wr == 1) PG8_BAR;
    PG8_WAIT_V(2); PG8_BAR;
    PG8_STAGE(PG8_SB(1, 0), cB + kstep, voffB); PG8_STAGE(PG8_SA(1, 0), cA + kstep, voffA); PG8_STAGE(PG8_SB(1, 1), cB + hstepB + kstep, voffB);
    PG8_WAIT_V(6); PG8_BAR;
    for (;;) {
        const bool has_next = S.next(ui + 1, nxt);
        const char* nA = has_next ? (const char*)g.A + (size_t)nxt.pm * tstepA : cA; const char* nB = has_next ? (const char*)g.Bt + (size_t)nxt.pn * tstepB : cB;
#pragma unroll 1
        for (int t = 0; t < nt; t += 2) {
            const bool last = (t == nt - 2);
            const char* a1 = cA + (size_t)(t + 1) * kstep;
            const char* a2 = last ? nA : cA + (size_t)(t + 2) * kstep; const char* b2 = last ? nB : cB + (size_t)(t + 2) * kstep;
            const char* a3 = a2 + kstep; const char* b3 = b2 + kstep;
            PG8_LDB(B0, 0, 0); PG8_LDB(B1, 0, 1); PG8_SCHED; PG8_LDA(At, 0, 0); PG8_STAGE(PG8_SA(1, 1), a1 + hstepA, voffA);
            PG8_WAIT_V(8); PG8_WAIT_L(0); PG8_BAR; PG8_MMA(0, 0, At, B0); PG8_MMA(0, 1, At, B1); PG8_BAR; PG8_SCHED;
            PG8_LDA(At, 0, 1); PG8_STAGE(PG8_SB(0, 0), b2, voffB); PG8_STAGE(PG8_SB(0, 1), b2 + hstepB, voffB); PG8_STAGE(PG8_SA(0, 0), a2, voffA);
            PG8_WAIT_V(8); PG8_WAIT_L(0); PG8_BAR; PG8_MMA(1, 0, At, B0); PG8_MMA(1, 1, At, B1); PG8_BAR; PG8_SCHED;
            PG8_LDB(B0, 1, 0); PG8_LDB(B1, 1, 1); PG8_SCHED; PG8_LDA(At, 1, 0); PG8_STAGE(PG8_SA(0, 1), a2 + hstepA, voffA);
            PG8_WAIT_V(8); PG8_WAIT_L(0); PG8_BAR; PG8_MMA(0, 0, At, B0); PG8_MMA(0, 1, At, B1); PG8_BAR; PG8_SCHED;
            PG8_LDA(At, 1, 1); PG8_STAGE(PG8_SB(1, 0), b3, voffB); PG8_STAGE(PG8_SB(1, 1), b3 + hstepB, voffB); PG8_STAGE(PG8_SA(1, 0), a3, voffA);
            PG8_WAIT_V(8); PG8_WAIT_L(0); PG8_BAR; PG8_MMA(1, 0, At, B0); PG8_MMA(1, 1, At, B1); PG8_BAR; PG8_SCHED;
        }
        if (wr == 0) PG8_BAR;
        E(acc, cur, wr, wc, fr, fq);
        if (!has_next) break;
#pragma unroll
        for (int a = 0; a < 2; ++a)
#pragma unroll
            for (int b = 0; b < 2; ++b)
#pragma unroll
                for (int m = 0; m < 4; ++m)
#pragma unroll
                    for (int n = 0; n < 2; ++n) acc[a][b][m][n] = (f32x4){0.f, 0.f, 0.f, 0.f};
        cur = nxt; cA = nA; cB = nB; ++ui;
        if (wr == 1) PG8_BAR;
    }
    PG8_WAIT_V(0);
    PG8_BAR;
#undef PG8_SA
#undef PG8_SB
#undef PG8_STAGE
#undef PG8_LDA
#undef PG8_LDB
#undef PG8_MMA
#undef PG8_WAIT_V
#undef PG8_WAIT_L
#undef PG8_BAR
#undef PG8_SCHED
}
}
using pg8::Unit;

typedef f32x4 Acc[2][2][4][2];

template <int LD, int S0, int NS>
__device__ __forceinline__ void rows_rstd(const float* st, int row0, int fq, float inv_n, float (&r)[2][4]) {
#pragma unroll
    for (int ai = 0; ai < 2; ++ai)
#pragma unroll
        for (int m = 0; m < 4; ++m) {
            const GAS float* p = (const GAS float*)st + (size_t)(row0 + ai * 128 + m * 16) * LD + S0;
            float s = 0.f;
            if (NS == 32) { const f32x4 a = *(const GAS f32x4*)(p + fq * 8), b = *(const GAS f32x4*)(p + fq * 8 + 4); s = (a.x + a.y) + (a.z + a.w) + (b.x + b.y) + (b.z + b.w); }
            else { if (fq * 4 < NS) { const f32x4 a = *(const GAS f32x4*)(p + fq * 4); s = (a.x + a.y) + (a.z + a.w); } }
            s += __shfl_xor(s, 16); s += __shfl_xor(s, 32);
            r[ai][m] = 1.0f / sqrtf(s * inv_n + EPS);
        }
}

struct EpiSwiglu {
    const float* ssq; bf16_t* act;
    __device__ __forceinline__ void operator()(const Acc& acc, const Unit& u, int wr, int wc, int fr, int fq) const {
        asm volatile("" : "+v"(fr), "+v"(fq));
        const int row0 = u.pm * 256 + wr * 64 + fr, col = u.pn * 128 + wc * 32 + 8 * fq;
        float rs[2][4]; rows_rstd<32, 0, 32>(ssq, row0, fq, 1.0f / D, rs);
#pragma unroll
        for (int ai = 0; ai < 2; ++ai)
#pragma unroll
            for (int m = 0; m < 4; ++m) { const float r = rs[ai][m]; float o[8];
#pragma unroll
                for (int n = 0; n < 2; ++n)
#pragma unroll
                    for (int j = 0; j < 4; ++j) { const float g = acc[ai][0][m][n][j] * r, up = acc[ai][1][m][n][j] * r;
                        o[4 * n + j] = g * __builtin_amdgcn_rcpf(1.0f + __builtin_amdgcn_exp2f(-g * LOG2E)) * up; }
                *(GAS u32x4*)((GAS bf16_t*)act + (size_t)(row0 + ai * 128 + m * 16) * FF + col) = pack8(o); __builtin_amdgcn_sched_barrier(0); }
    }
};

struct EpiResid {
    bf16_t* hb; float* ssq; float coef;
    __device__ __forceinline__ void operator()(const Acc& acc, const Unit& u, int wr, int wc, int fr, int fq) const {
        asm volatile("" : "+v"(fr), "+v"(fq));
        const int row0 = u.pm * 256 + wr * 64 + fr, col0 = u.pn * 256 + wc * 32 + 8 * fq;
        GAS bf16_t* hg = (GAS bf16_t*)hb;
#pragma unroll
        for (int ai = 0; ai < 2; ++ai) {
            u32x4 hv[4][2];
#pragma unroll
            for (int m = 0; m < 4; ++m)
#pragma unroll
                for (int bj = 0; bj < 2; ++bj) hv[m][bj] = *(const GAS u32x4*)(hg + (size_t)(row0 + ai * 128 + m * 16) * D + col0 + bj * 128);
            __builtin_amdgcn_sched_barrier(0);
#pragma unroll
            for (int m = 0; m < 4; ++m) { const int row = row0 + ai * 128 + m * 16; float ss = 0.f;
#pragma unroll
                for (int bj = 0; bj < 2; ++bj) { const size_t off = (size_t)row * D + col0 + bj * 128; const u32x4 hh = hv[m][bj];
                    const f32x4 h0 = (f32x4){bf_lo(hh.x), bf_hi(hh.x), bf_lo(hh.y), bf_hi(hh.y)}, h1 = (f32x4){bf_lo(hh.z), bf_hi(hh.z), bf_lo(hh.w), bf_hi(hh.w)};
                    const f32x4 v0 = h0 + coef * acc[ai][bj][m][0], v1 = h1 + coef * acc[ai][bj][m][1];
                    u32x4 w; w.x = cvt_pk_bf16(v0[0], v0[1]); w.y = cvt_pk_bf16(v0[2], v0[3]); w.z = cvt_pk_bf16(v1[0], v1[1]); w.w = cvt_pk_bf16(v1[2], v1[3]);
                    *(GAS u32x4*)(hg + off) = w;
                    ss += (v0[0] * v0[0] + v0[1] * v0[1]) + (v0[2] * v0[2] + v0[3] * v0[3]) + (v1[0] * v1[0] + v1[1] * v1[1]) + (v1[2] * v1[2] + v1[3] * v1[3]); }
                ss += __shfl_xor(ss, 16); ss += __shfl_xor(ss, 32);
                if (fq == 0) ((GAS float*)ssq)[(size_t)row * 32 + u.pn * 4 + wc] = ss; }
            __builtin_amdgcn_sched_barrier(0);
        }
    }
};

__device__ __forceinline__ void rope4(float pos, const float (&inv)[4], float* lo, float* hi) {
#pragma unroll
    for (int j = 0; j < 4; ++j) { float s, c; sincos_rev(pos * inv[j], s, c); const float a = lo[j], b = hi[j]; lo[j] = a * c - b * s; hi[j] = b * c + a * s; }
}

struct EpiInEven {
    const float* ssq; const int* pos; bf16_t* proj; float* ste; bf16_t* kf;
    __device__ __forceinline__ void operator()(const Acc& acc, const Unit& u, int wr, int wc, int fr, int fq) const {
        asm volatile("" : "+v"(fr), "+v"(fq));
        const int row0 = u.pm * 256 + wr * 64 + fr, pn = u.pn, colw = pn * 256 + wc * 32 + 8 * fq;
        float rs[2][4]; rows_rstd<32, 0, 32>(ssq, row0, fq, 1.0f / D, rs);
        if (pn < 6) {
            const float qs = pn < 3 ? QSCALE_A : 1.0f;
            float inv[4];
#pragma unroll
            for (int j = 0; j < 4; ++j) inv[j] = __builtin_amdgcn_exp2f(-(float)(16 * wc + 4 * fq + j) * (L2THETA / 64.0f));
#pragma unroll
            for (int ai = 0; ai < 2; ++ai)
#pragma unroll
                for (int m = 0; m < 4; ++m) { const int row = row0 + ai * 128 + m * 16; const float p = (float)((const GAS int*)pos)[row], sc = rs[ai][m] * qs;
                    float sn[4], cs[4];
#pragma unroll
                    for (int j = 0; j < 4; ++j) sincos_rev(p * inv[j], sn[j], cs[j]);
#pragma unroll
                    for (int bj = 0; bj < 2; ++bj) { float o[8];
#pragma unroll
                        for (int j = 0; j < 4; ++j) { const float a = acc[ai][bj][m][0][j] * sc, b = acc[ai][bj][m][1][j] * sc; o[j] = a * cs[j] - b * sn[j]; o[4 + j] = b * cs[j] + a * sn[j]; }
                        *(GAS u32x4*)((GAS bf16_t*)proj + (size_t)row * INE + colw + bj * 128) = pack8(o); } __builtin_amdgcn_sched_barrier(0); }
        } else {
            float inv[4];
#pragma unroll
            for (int j = 0; j < 4; ++j) inv[j] = __builtin_amdgcn_exp2f(-(float)(4 * fq + j) * (L2THETA / 16.0f));
#pragma unroll
            for (int ai = 0; ai < 2; ++ai)
#pragma unroll
                for (int m = 0; m < 4; ++m) { const int row = row0 + ai * 128 + m * 16; const float r = rs[ai][m];
#pragma unroll
                    for (int bj = 0; bj < 2; ++bj) { float o[8]; float ss = 0.f;
#pragma unroll
                        for (int n = 0; n < 2; ++n)
#pragma unroll
                            for (int j = 0; j < 4; ++j) { o[4 * n + j] = acc[ai][bj][m][n][j] * r; ss += o[4 * n + j] * o[4 * n + j]; }
                        if (pn == 11 && bj == 1) {
                            if (wc == 0) { rope4((float)((const GAS int*)pos)[row], inv, o, o + 4); const u32x4 w = pack8(o);
#pragma unroll
                                for (int hh = 0; hh < 4; ++hh) *(GAS u32x4*)((GAS bf16_t*)kf + (size_t)row * 384 + hh * 96 + 64 + 8 * fq) = w; }
                        } else {
                            *(GAS u32x4*)((GAS bf16_t*)proj + (size_t)row * INE + colw + bj * 128) = pack8(o);
                            if (pn >= 9) { ss += __shfl_xor(ss, 16); ss += __shfl_xor(ss, 32); if (fq == 0) ((GAS float*)ste)[(size_t)row * 24 + (pn - 9) * 8 + bj * 4 + wc] = ss; }
                        } } __builtin_amdgcn_sched_barrier(0); }
        }
    }
};

struct EpiQup {
    const float* ste; const int* pos; bf16_t* qf;
    __device__ __forceinline__ void operator()(const Acc& acc, const Unit& u, int wr, int wc, int fr, int fq) const {
        asm volatile("" : "+v"(fr), "+v"(fq));
        const int row0 = u.pm * 256 + wr * 64 + fr;
        float rs[2][4]; rows_rstd<24, 0, 12>(ste, row0, fq, 1.0f / 384.0f, rs);
        float inv[4];
#pragma unroll
        for (int j = 0; j < 4; ++j) inv[j] = __builtin_amdgcn_exp2f(-(float)(4 * fq + j) * (L2THETA / 16.0f));
#pragma unroll
        for (int bj = 0; bj < 2; ++bj) { const int g = 8 * u.pn + 4 * bj + wc; if (g >= 12) continue; const int hd = g / 3, part = g - 3 * hd;
#pragma unroll
            for (int ai = 0; ai < 2; ++ai)
#pragma unroll
                for (int m = 0; m < 4; ++m) { const int row = row0 + ai * 128 + m * 16; const float r = rs[ai][m] * QSCALE_B; float o[8];
#pragma unroll
                    for (int n = 0; n < 2; ++n)
#pragma unroll
                        for (int j = 0; j < 4; ++j) o[4 * n + j] = acc[ai][bj][m][n][j] * r;
                    if (part == 2) rope4((float)((const GAS int*)pos)[row], inv, o, o + 4);
                    *(GAS u32x4*)((GAS bf16_t*)qf + (size_t)row * 384 + hd * 96 + part * 32 + 8 * fq) = pack8(o); __builtin_amdgcn_sched_barrier(0); } }
    }
};

struct EpiKvup {
    const float* ste; bf16_t* kf; bf16_t* vb;
    __device__ __forceinline__ void operator()(const Acc& acc, const Unit& u, int wr, int wc, int fr, int fq) const {
        asm volatile("" : "+v"(fr), "+v"(fq));
        const int row0 = u.pm * 256 + wr * 64 + fr;
        float rs[2][4]; rows_rstd<24, 12, 8>(ste, row0, fq, 1.0f / 256.0f, rs);
#pragma unroll
        for (int bj = 0; bj < 2; ++bj) { const int g = 8 * u.pn + 4 * bj + wc; const int hd = g / 6, part = g - 6 * hd;
#pragma unroll
            for (int ai = 0; ai < 2; ++ai)
#pragma unroll
                for (int m = 0; m < 4; ++m) { const int row = row0 + ai * 128 + m * 16; const float r = rs[ai][m]; float o[8];
#pragma unroll
                    for (int n = 0; n < 2; ++n)
#pragma unroll
                        for (int j = 0; j < 4; ++j) o[4 * n + j] = acc[ai][bj][m][n][j] * r;
                    bf16_t* dst = part < 2 ? kf + (size_t)row * 384 + hd * 96 + part * 32 + 8 * fq : vb + (size_t)row * 512 + hd * 128 + (part - 2) * 32 + 8 * fq;
                    *(GAS u32x4*)(GAS bf16_t*)dst = pack8(o); __builtin_amdgcn_sched_barrier(0); } }
    }
};

struct EpiInOdd {
    const float* ssq; bf16_t* proj;
    __device__ __forceinline__ void operator()(const Acc& acc, const Unit& u, int wr, int wc, int fr, int fq) const {
        asm volatile("" : "+v"(fr), "+v"(fq));
        const int row0 = u.pm * 256 + wr * 64 + fr, colw = u.pn * 256 + wc * 32 + 8 * fq;
        float rs[2][4]; rows_rstd<32, 0, 32>(ssq, row0, fq, 1.0f / D, rs);
        const float qs = (u.pn == 2 || u.pn == 3) ? QSCALE_D : 1.0f;
#pragma unroll
        for (int ai = 0; ai < 2; ++ai)
#pragma unroll
            for (int m = 0; m < 4; ++m) { const int row = row0 + ai * 128 + m * 16; const float r = rs[ai][m] * qs;
#pragma unroll
                for (int bj = 0; bj < 2; ++bj) { float o[8];
#pragma unroll
                    for (int n = 0; n < 2; ++n)
#pragma unroll
                        for (int j = 0; j < 4; ++j) o[4 * n + j] = acc[ai][bj][m][n][j] * r;
                    *(GAS u32x4*)((GAS bf16_t*)proj + (size_t)row * INO + colw + bj * 128) = pack8(o); } __builtin_amdgcn_sched_barrier(0); }
    }
};

template <int MODE>
__device__ __forceinline__ void tile_desc(int i, int u0, int r4, int& tok0, int& st, int& dil) {
    if (MODE == 0) {
        if (i < 18) { dil = 1; st = 1; tok0 = 4 * u0 - 128 + 64 * i; }
        else if (i < 24) { const int j = i - 18; dil = 4; st = 4; tok0 = r4 + 4 * (u0 - 128 + 64 * j); }
        else { const int j = i - 24, c = j / 3, jj = j - 3 * c; dil = 16; st = 16; tok0 = r4 + 4 * c + 16 * (u0 / 4 - 128 + 64 * jj); }
    } else { dil = 1; st = 1; tok0 = 64 * i; }
}
__device__ __forceinline__ float xhalf(float v, int h) { const unsigned u = __builtin_bit_cast(unsigned, v); auto rr = __builtin_amdgcn_permlane32_swap(u, u, false, false);
    return __builtin_bit_cast(float, h == 0 ? (unsigned)rr[1] : (unsigned)rr[0]); }
__device__ __forceinline__ s16x4 vtr(const LAS unsigned char* p) { return __builtin_bit_cast(s16x4, __builtin_amdgcn_ds_read_tr16_b64_v4i16((LAS s16x4*)p)); }

template <int MODE>
__device__ __forceinline__ void att_smpv(f32x16 (&s)[2], f32x16 (&o)[4], float& mrun, float& lrun, float& Rrun, int tq, int tqmin, int tok0, int st, int dil, int h, int lane, const LAS unsigned char* vb) {
    const int d0 = tq - tok0 - st * 4 * h;
    bf16x8 pf[2][2];
#define ATT_PACK(src, kk) do { _Pragma("unroll") for (int s2 = 0; s2 < 2; ++s2) { u32x4 w_; w_.x = cvt_pk_bf16(src[8 * s2], src[8 * s2 + 1]); w_.y = cvt_pk_bf16(src[8 * s2 + 2], src[8 * s2 + 3]); \
            w_.z = cvt_pk_bf16(src[8 * s2 + 4], src[8 * s2 + 5]); w_.w = cvt_pk_bf16(src[8 * s2 + 6], src[8 * s2 + 7]); pf[kk][s2] = __builtin_bit_cast(bf16x8, w_); } } while (0)
    if (MODE != 2) {
        const bool need_mask = (MODE == 0) || (tok0 + 63 > tqmin);
        if (need_mask) {
#pragma unroll
            for (int kk = 0; kk < 2; ++kk)
#pragma unroll
                for (int e = 0; e < 16; ++e) { const int d = d0 - st * (32 * kk + 8 * (e >> 2) + (e & 3));
                    const bool ok = (MODE == 0) ? ((unsigned)d <= 128u * (unsigned)dil && (d & (dil - 1)) == 0) : (d >= 0);
                    s[kk][e] = ok ? s[kk][e] : -INFINITY; }
        }
        float mx = fmaxf(fmaxf(s[0][0], s[1][0]), fmaxf(s[0][1], s[1][1]));
#pragma unroll
        for (int e = 2; e < 16; e += 2) { mx = fmaxf(fmaxf(mx, s[0][e]), s[1][e]); mx = fmaxf(fmaxf(mx, s[0][e + 1]), s[1][e + 1]); }
        mx = fmaxf(mx, xhalf(mx, h));
        if (__any(mx > mrun)) {
            const float mnew = fmaxf(mrun, mx), alpha = __builtin_amdgcn_exp2f(mrun - mnew); mrun = mnew; lrun *= alpha;
#pragma unroll
            for (int b = 0; b < 4; ++b)
#pragma unroll
                for (int e = 0; e < 16; ++e) o[b][e] *= alpha;
        }
        f32x2 ps2 = (f32x2){0.f, 0.f};
#pragma unroll
        for (int kk = 0; kk < 2; ++kk)
#pragma unroll
            for (int e = 0; e < 16; e += 2) { const float p0 = __builtin_amdgcn_exp2f(s[kk][e] - mrun), p1 = __builtin_amdgcn_exp2f(s[kk][e + 1] - mrun); s[kk][e] = p0; s[kk][e + 1] = p1; ps2 += (f32x2){p0, p1}; }
        lrun += ps2.x + ps2.y;
        ATT_PACK(s[0], 0); ATT_PACK(s[1], 1);
    } else {
        float run = Rrun;
        const bool need_mask = tok0 + 63 >= tqmin;
#pragma unroll
        for (int kk = 1; kk >= 0; --kk) {
            if (need_mask) {
#pragma unroll
                for (int e = 0; e < 16; ++e) { const int d = d0 - st * (32 * kk + 8 * (e >> 2) + (e & 3)); s[kk][e] = d > 0 ? s[kk][e] : -INFINITY; }
            }
            float zm = fmaxf(fmaxf(s[kk][0], s[kk][1]), s[kk][2]);
#pragma unroll
            for (int e = 3; e < 15; e += 2) zm = fmaxf(fmaxf(zm, s[kk][e]), s[kk][e + 1]);
            zm = fmaxf(zm, s[kk][15]);
            if (!__any(zm > 30.0f)) {
                float tt[16], gs[4], pg[4];
#pragma unroll
                for (int e = 0; e < 16; ++e) { s[kk][e] = __builtin_amdgcn_exp2f(s[kk][e]); tt[e] = 1.0f + s[kk][e]; }
#pragma unroll
                for (int g = 0; g < 4; ++g) { const float p0 = (tt[4 * g] * tt[4 * g + 1]) * (tt[4 * g + 2] * tt[4 * g + 3]); gs[g] = __builtin_amdgcn_logf(p0); pg[g] = xhalf(gs[g], h);
                    tt[4 * g + 3] = __builtin_amdgcn_rcpf(p0); }
#pragma unroll
                for (int g = 3; g >= 0; --g) { const float c = run + (h == 0 ? pg[g] : 0.f); run += gs[g] + pg[g];
                    const float rr = tt[4 * g + 3] * __builtin_amdgcn_exp2f(-c), q1 = tt[4 * g], q2 = q1 * tt[4 * g + 1], q3 = q2 * tt[4 * g + 2];
                    s[kk][4 * g] = s[kk][4 * g] * rr; s[kk][4 * g + 1] = (s[kk][4 * g + 1] * q1) * rr; s[kk][4 * g + 2] = (s[kk][4 * g + 2] * q2) * rr; s[kk][4 * g + 3] = (s[kk][4 * g + 3] * q3) * rr; }
            } else {
                float sp[16];
#pragma unroll
                for (int e = 0; e < 16; ++e) { const float z = s[kk][e]; sp[e] = fmaxf(z, 0.f) + __builtin_amdgcn_logf(1.0f + __builtin_amdgcn_exp2f(-fabsf(z))); }
                float gs[4], pg[4];
#pragma unroll
                for (int g = 0; g < 4; ++g) { gs[g] = (sp[4 * g] + sp[4 * g + 1]) + (sp[4 * g + 2] + sp[4 * g + 3]); pg[g] = xhalf(gs[g], h); }
#pragma unroll
                for (int g = 3; g >= 0; --g) { float c = run + (h == 0 ? pg[g] : 0.f); run += gs[g] + pg[g];
#pragma unroll
                    for (int jj = 3; jj >= 0; --jj) { const int e = 4 * g + jj; c += sp[e]; s[kk][e] = __builtin_amdgcn_exp2f(s[kk][e] - c); } }
            }
            ATT_PACK(s[kk], kk);
            __builtin_amdgcn_sched_barrier(0);
        }
        Rrun = run;
    }
#undef ATT_PACK
    const int li = lane & 15, tq_ = li >> 2, tp = li & 3;
    const unsigned base0 = (unsigned)((4 * h + tq_) * 256 + (tq_ << 6) + (2 * ((lane >> 4) & 1) + (tp >> 1)) * 16 + 8 * (tp & 1));
#pragma unroll
    for (int b = 0; b < 4; ++b)
#pragma unroll
        for (int kk = 0; kk < 2; ++kk)
#pragma unroll
            for (int s2 = 0; s2 < 2; ++s2) { const LAS unsigned char* p = vb + ((base0 ^ (unsigned)(b << 6)) + (unsigned)((32 * kk + 16 * s2) * 256));
                const s16x4 lo = vtr(p), hi = vtr(p + 8 * 256);
                const bf16x8 vf = (bf16x8){lo[0], lo[1], lo[2], lo[3], hi[0], hi[1], hi[2], hi[3]};
                o[b] = __builtin_amdgcn_mfma_f32_32x32x16_bf16(vf, pf[kk][s2], o[b], 0, 0, 0); }
}

template <int DK, int MODE>
__device__ __forceinline__ void attn_unit(LAS unsigned char* lds, const bf16_t* Q, int ldq, const bf16_t* Kp, int ldk, const bf16_t* Vp, int ldv, bf16_t* O, int ldo, int u0, int r4) {
    constexpr int KBYTES = 16384, BUF = 32768, KCH = DK / 8, NB = 4;
    int tid = threadIdx.x; asm volatile("" : "+v"(tid));
    const GAS bf16_t* Qg = (const GAS bf16_t*)Q; GAS bf16_t* Og = (GAS bf16_t*)O;
    const int wave = __builtin_amdgcn_readfirstlane(tid >> 6), lane = tid & 63, r = lane & 31, h = lane >> 5;
    int tq, tqmin, tqmax;
    if (MODE == 0) { tqmin = r4 + 4 * (u0 + 32 * wave); tq = tqmin + 4 * r; tqmax = tqmin + 124; }
    else { tqmin = 256 * u0 + 32 * wave; tq = tqmin + r; tqmax = tqmin + 31; }
    bf16x8 qf[DK / 16];
#pragma unroll
    for (int ks = 0; ks < DK / 16; ++ks) qf[ks] = *(const GAS bf16x8*)(Qg + (size_t)tq * ldq + 16 * ks + 8 * h);
    f32x16 o[4];
#pragma unroll
    for (int b = 0; b < 4; ++b)
#pragma unroll
        for (int e = 0; e < 16; ++e) o[b][e] = 0.f;
    float mrun = -1e30f, lrun = 0.f, Rrun = 0.f;
    const int ntiles = (MODE == 0) ? 36 : 4 * (u0 + 1);
    const int drow = lane >> 4, dpos = lane & 15;
    const int kchunk0 = dpos ^ ((8 * wave + drow) & 15), vchunk = dpos ^ (4 * (drow & 3));
#define ATT_IDX(i) ((MODE == 2) ? (ntiles - 1 - (i)) : (MODE == 0) ? (((i) < 18) ? (((i) >> 1) + 9 * ((i) & 1)) : ((i) < 24) ? (18 + (((i) - 18) >> 1) + 3 * ((i) & 1)) : (i)) : (i))
    const unsigned kvo0 = (unsigned)((8 * wave + drow) * ldk * 2), vvo0 = (unsigned)((8 * wave + drow) * ldv * 2);
    const unsigned kc0b = (unsigned)(kchunk0 * 16), vcb = (unsigned)(vchunk * 16);
#define ATT_DMA(tok0_, st_, buf_) do { LAS unsigned char* kb_ = lds + (buf_) * BUF + wave * 2048; \
        const int sh_ = (MODE != 0 || (st_) == 1) ? 0 : ((st_) == 4 ? 2 : 4); \
        const char* kt_ = (const char*)Kp + (size_t)(tok0_) * ldk * 2; const char* vt_ = (const char*)Vp + (size_t)(tok0_) * ldv * 2; \
        if (kchunk0 < KCH) __builtin_amdgcn_global_load_lds((const unsigned*)(kt_ + ((kvo0 << sh_) + kc0b)), (LAS unsigned*)(kb_), 16, 0, 0); \
        if ((kchunk0 ^ 4) < KCH) __builtin_amdgcn_global_load_lds((const unsigned*)(kt_ + (((kvo0 + (unsigned)(8 * ldk)) << sh_) + (kc0b ^ 64u))), (LAS unsigned*)(kb_ + 1024), 16, 0, 0); \
        __builtin_amdgcn_global_load_lds((const unsigned*)(vt_ + ((vvo0 << sh_) + vcb)), (LAS unsigned*)(kb_ + KBYTES), 16, 0, 0); \
        __builtin_amdgcn_global_load_lds((const unsigned*)(vt_ + (((vvo0 + (unsigned)(8 * ldv)) << sh_) + vcb)), (LAS unsigned*)(kb_ + KBYTES + 1024), 16, 0, 0); } while (0)
#define ATT_KLD(kb, kk, ks) (*(const LAS bf16x8*)((kb) + (32 * (kk) + r) * 256 + (((2 * (ks) + h) ^ (r & 15)) << 4)))
#define ATT_QK2(d0_, d1_, kb) do { _Pragma("unroll") for (int e = 0; e < 16; ++e) { d0_[e] = 0.f; d1_[e] = 0.f; } \
        bf16x8 ka_[2][2]; ka_[0][0] = ATT_KLD(kb, 0, 0); ka_[0][1] = ATT_KLD(kb, 1, 0); ka_[1][0] = ATT_KLD(kb, 0, 1); ka_[1][1] = ATT_KLD(kb, 1, 1); \
        __builtin_amdgcn_sched_barrier(0); \
        _Pragma("unroll") for (int ks = 0; ks < DK / 16; ++ks) { \
            d0_ = __builtin_amdgcn_mfma_f32_32x32x16_bf16(ka_[ks & 1][0], qf[ks], d0_, 0, 0, 0); d1_ = __builtin_amdgcn_mfma_f32_32x32x16_bf16(ka_[ks & 1][1], qf[ks], d1_, 0, 0, 0); \
            __builtin_amdgcn_sched_barrier(0); \
            if (ks + 2 < DK / 16) { ka_[ks & 1][0] = ATT_KLD(kb, 0, ks + 2); ka_[ks & 1][1] = ATT_KLD(kb, 1, ks + 2); } \
            __builtin_amdgcn_sched_barrier(0); } } while (0)
#define ATT_REL(tok0_, st_, dil_) ((MODE == 0) ? (((tok0_) + 63 * (st_) >= tqmin - 128 * (dil_)) && ((tok0_) <= tqmax)) : ((tok0_) <= tqmax))
    const int npairs = ntiles >> 1;
#define ATT_DMAPAIR(p_) do { _Pragma("unroll") for (int s_ = 0; s_ < 2; ++s_) { int tk_, sv_, dv_; tile_desc<MODE>(ATT_IDX(2 * (p_) + s_), u0, r4, tk_, sv_, dv_); \
            if (tk_ >= 0) ATT_DMA(tk_, sv_, 2 * ((p_) & 1) + s_); } } while (0)
    __syncthreads();
    ATT_DMAPAIR(0);
    asm volatile("s_waitcnt vmcnt(0)" ::: "memory");
    __builtin_amdgcn_s_barrier(); asm volatile("" ::: "memory");
    for (int p = 0; p < npairs; ++p) {
        if (p + 1 < npairs) ATT_DMAPAIR(p + 1);
#pragma unroll
        for (int s_ = 0; s_ < 2; ++s_) { int tok0, st, dil; tile_desc<MODE>(ATT_IDX(2 * p + s_), u0, r4, tok0, st, dil);
            const LAS unsigned char* kb = lds + (2 * (p & 1) + s_) * BUF;
            if (tok0 >= 0 && ATT_REL(tok0, st, dil)) { f32x16 s[2]; ATT_QK2(s[0], s[1], kb); att_smpv<MODE>(s, o, mrun, lrun, Rrun, tq, tqmin, tok0, st, dil, h, lane, kb + KBYTES); } }
        asm volatile("s_waitcnt vmcnt(0)" ::: "memory");
        __builtin_amdgcn_s_barrier(); asm volatile("" ::: "memory");
    }
#undef ATT_DMAPAIR
    float sc = 1.0f;
    if (MODE != 2) { const float lt = lrun + xhalf(lrun, h); sc = 1.0f / lt; }
#pragma unroll
    for (int b = 0; b < 4; ++b)
#pragma unroll
        for (int k2 = 0; k2 < 2; ++k2) {
            const int ga = 2 * k2, gb = 2 * k2 + 1;
            const unsigned a0 = cvt_pk_bf16(o[b][4 * ga] * sc, o[b][4 * ga + 1] * sc), a1 = cvt_pk_bf16(o[b][4 * ga + 2] * sc, o[b][4 * ga + 3] * sc);
            const unsigned b0 = cvt_pk_bf16(o[b][4 * gb] * sc, o[b][4 * gb + 1] * sc), b1 = cvt_pk_bf16(o[b][4 * gb + 2] * sc, o[b][4 * gb + 3] * sc);
            auto r0 = __builtin_amdgcn_permlane32_swap(a0, b0, false, false); auto r1 = __builtin_amdgcn_permlane32_swap(a1, b1, false, false);
            u32x4 w; w.x = (unsigned)r0[0]; w.y = (unsigned)r1[0]; w.z = (unsigned)r0[1]; w.w = (unsigned)r1[1];
            *(GAS u32x4*)(Og + (size_t)tq * ldo + 32 * b + 16 * k2 + 8 * h) = w; }
#undef ATT_IDX
#undef ATT_DMA
#undef ATT_KLD
#undef ATT_QK2
#undef ATT_REL
}

template <int W>
__device__ __forceinline__ bf16x8 pool_frag(const GAS bf16_t* up, int cnt, float icnt) {
    u32x4 v[W];
#pragma unroll
    for (int j = 0; j < W; ++j) v[j] = *(const GAS u32x4*)(up - (size_t)(j < cnt ? j : 0) * INO);
    float sum[8];
#pragma unroll
    for (int e = 0; e < 8; ++e) sum[e] = 0.f;
#pragma unroll
    for (int j = 0; j < W; ++j) { const float m = j < cnt ? 1.0f : 0.0f;
        sum[0] += m * bf_lo(v[j].x); sum[1] += m * bf_hi(v[j].x); sum[2] += m * bf_lo(v[j].y); sum[3] += m * bf_hi(v[j].y);
        sum[4] += m * bf_lo(v[j].z); sum[5] += m * bf_hi(v[j].z); sum[6] += m * bf_lo(v[j].w); sum[7] += m * bf_hi(v[j].w); }
    const u32x4 self = v[0]; float o[8];
    o[0] = sum[0] * icnt - bf_lo(self.x); o[1] = sum[1] * icnt - bf_hi(self.x); o[2] = sum[2] * icnt - bf_lo(self.y); o[3] = sum[3] * icnt - bf_hi(self.y);
    o[4] = sum[4] * icnt - bf_lo(self.z); o[5] = sum[5] * icnt - bf_hi(self.z); o[6] = sum[6] * icnt - bf_lo(self.w); o[7] = sum[7] * icnt - bf_hi(self.w);
    return __builtin_bit_cast(bf16x8, pack8(o));
}
__device__ __forceinline__ void pool_unit(const bf16_t* proj, const bf16_t* pw, const float* scale, bf16_t* mrg, int wu, int lane) {
    const int g = (wu + (wu >> 11)) & 3, rb = wu >> 2, fr = lane & 15, fq = lane >> 4;
    const int row = rb * 16 + fr, t = row & (SEQ - 1), w = 2 << g;
    const int cnt = (t + 1 < w) ? (t + 1) : w; const float icnt = 1.0f / (float)cnt;
    bf16x8 pfr[4];
#pragma unroll
    for (int ks = 0; ks < 4; ++ks) { const GAS bf16_t* up = (const GAS bf16_t*)proj + (size_t)row * INO + g * 128 + 32 * ks + 8 * fq;
        if (g == 0) pfr[ks] = pool_frag<2>(up, cnt, icnt); else if (g == 1) pfr[ks] = pool_frag<4>(up, cnt, icnt); else if (g == 2) pfr[ks] = pool_frag<8>(up, cnt, icnt); else pfr[ks] = pool_frag<16>(up, cnt, icnt); }
#pragma unroll
    for (int nt = 0; nt < 8; ++nt) { f32x4 acc = (f32x4){0.f, 0.f, 0.f, 0.f};
#pragma unroll
        for (int ks = 0; ks < 4; ++ks) { const bf16x8 wf = *(const GAS bf16x8*)((const GAS bf16_t*)pw + (size_t)(g * 128 + 16 * nt + fr) * 128 + 32 * ks + 8 * fq);
            acc = __builtin_amdgcn_mfma_f32_16x16x32_bf16(wf, pfr[ks], acc, 0, 0, 0); }
        const int e0 = g * 128 + 16 * nt + 4 * fq; const f32x4 sc = *(const GAS f32x4*)((const GAS float*)scale + e0);
        u32x2 wv; wv.x = cvt_pk_bf16(acc[0] * sc[0], acc[1] * sc[1]); wv.y = cvt_pk_bf16(acc[2] * sc[2], acc[3] * sc[3]);
        *(GAS u32x2*)((GAS bf16_t*)mrg + (size_t)row * DMO + e0) = wv; }
}

__device__ __forceinline__ int map_row(int mode, int n) {
    if (mode == 1) return (n >> 7) * 256 + (n & 127);
    if (mode == 2) return (n >> 7) * 256 + 128 + (n & 127);
    if (mode == 3) {
        if (n < 1536) { const int d = n & 127, nb = d >> 6, low = d & 63; return (n & ~127) + ((low >> 4) << 5) + (((low >> 2) & 3) << 3) + (nb << 2) + (low & 3); }
        if (n >= 2944) { const int d = n - 2944, nb = d >> 4, low = d & 15; return 2944 + ((low >> 2) << 3) + (nb << 2) + (low & 3); }
        return n;
    }
    if (mode == 4) { const int hd = n / 96; int d = n - hd * 96; if (d < 64) return n; d -= 64; const int nb = d >> 4, low = d & 15; return hd * 96 + 64 + ((low >> 2) << 3) + (nb << 2) + (low & 3); }
    return n;
}
struct TItem { const float* W; const float* gain; bf16_t* WT; int K, N, mode, item; };
__device__ __forceinline__ void titem_load(const TItem& t, float (&rg)[32], int lane) {
    const int nblk = t.N / 32, kb = t.item / nblk, nb = t.item - kb * nblk, k0 = 64 * kb, n0 = 32 * nb;
#pragma unroll
    for (int i = 0; i < 32; ++i) { const int kk = 2 * i + (lane >> 5); const float gg = t.gain ? ((const GAS float*)t.gain)[k0 + kk] : 1.0f; rg[i] = ((const GAS float*)t.W)[(size_t)(k0 + kk) * t.N + n0 + (lane & 31)] * gg; }
}
__device__ __forceinline__ void titem_finish(const TItem& t, const float (&rg)[32], LAS float* scr, int lane) {
    const int nblk = t.N / 32, kb = t.item / nblk, nb = t.item - kb * nblk, k0 = 64 * kb, n0 = 32 * nb;
#pragma unroll
    for (int i = 0; i < 32; ++i) { const int kk = 2 * i + (lane >> 5); scr[kk * 33 + (lane & 31)] = rg[i]; }
    asm volatile("s_waitcnt lgkmcnt(0)" ::: "memory");
    const int c = lane & 7;
#pragma unroll
    for (int j = 0; j < 4; ++j) { const int n = (lane >> 3) + 8 * j; const LAS float* sp = scr + (8 * c) * 33 + n;
        u32x4 o; o.x = cvt_pk_bf16(sp[0 * 33], sp[1 * 33]); o.y = cvt_pk_bf16(sp[2 * 33], sp[3 * 33]); o.z = cvt_pk_bf16(sp[4 * 33], sp[5 * 33]); o.w = cvt_pk_bf16(sp[6 * 33], sp[7 * 33]);
        *(GAS u32x4*)((GAS bf16_t*)t.WT + (size_t)map_row(t.mode, n0 + n) * t.K + k0 + 8 * c) = o; }
    asm volatile("s_waitcnt lgkmcnt(0)" ::: "memory");
}

struct Args { const float* in[17]; float* out; unsigned char* ws; int lo, hi; };
typedef const __attribute__((address_space(4))) Args* ArgsP;

__device__ __forceinline__ void prologue(ArgsP ap, unsigned char* ws, LAS unsigned char* lds, int gw, int ngw, int wave, int lane) {
    LAS float* scr = (LAS float*)(lds + wave * 16384);
    const float* ng = ap->in[2];
    constexpr int I_GU = 32 * 48, I_DN = 24 * 64, I_INE = 32 * 93, I_INO = 32 * 64, I_QUP = 6 * 12, I_KVUP = 4 * 24, I_OUTE = 20 * 64, I_OUTO = 16 * 64, I_POOL = 2 * 4;
    constexpr int NITEMS = 8 * I_GU + 4 * I_DN + I_INE + I_INO + I_QUP + I_KVUP + I_OUTE + I_OUTO + 4 * I_POOL;
    auto decode = [&](int it) -> TItem {
        TItem t; int r = it;
        if (r < 8 * I_GU) { const int w = r / I_GU, f = w >> 1, up = w & 1; r -= w * I_GU;
            t.W = (up ? ap->in[4] : ap->in[3]) + (size_t)f * D * FF; t.gain = ng + (size_t)((f >> 1) * 3 + ((f & 1) ? 2 : 0)) * D;
            t.WT = (bf16_t*)(ws + WS_WGU) + (size_t)f * 3072 * D; t.K = D; t.N = FF; t.mode = up ? 2 : 1; t.item = r; return t; }
        r -= 8 * I_GU;
        if (r < 4 * I_DN) { const int f = r / I_DN; r -= f * I_DN; t.W = ap->in[5] + (size_t)f * FF * D; t.gain = nullptr; t.WT = (bf16_t*)(ws + WS_WD) + (size_t)f * D * FF; t.K = FF; t.N = D; t.mode = 0; t.item = r; return t; }
        r -= 4 * I_DN;
        if (r < I_INE) { t.W = ap->in[6]; t.gain = ng + 1 * D; t.WT = (bf16_t*)(ws + WS_WINE); t.K = D; t.N = 2976; t.mode = 3; t.item = r; return t; } r -= I_INE;
        if (r < I_INO) { t.W = ap->in[12]; t.gain = ng + 4 * D; t.WT = (bf16_t*)(ws + WS_WINO); t.K = D; t.N = INO; t.mode = 0; t.item = r; return t; } r -= I_INO;
        if (r < I_QUP) { t.W = ap->in[8]; t.gain = ap->in[7]; t.WT = (bf16_t*)(ws + WS_WQUP); t.K = 384; t.N = 384; t.mode = 4; t.item = r; return t; } r -= I_QUP;
        if (r < I_KVUP) { t.W = ap->in[10]; t.gain = ap->in[9]; t.WT = (bf16_t*)(ws + WS_WKVUP); t.K = 256; t.N = 768; t.mode = 0; t.item = r; return t; } r -= I_KVUP;
        if (r < I_OUTE) { t.W = ap->in[11]; t.gain = nullptr; t.WT = (bf16_t*)(ws + WS_WOUTE); t.K = DME; t.N = D; t.mode = 0; t.item = r; return t; } r -= I_OUTE;
        if (r < I_OUTO) { t.W = ap->in[15]; t.gain = nullptr; t.WT = (bf16_t*)(ws + WS_WOUTO); t.K = DMO; t.N = D; t.mode = 0; t.item = r; return t; } r -= I_OUTO;
        { const int g = r / I_POOL; r -= g * I_POOL; t.W = ap->in[13] + (size_t)g * 128 * 128; t.gain = nullptr; t.WT = (bf16_t*)(ws + WS_POOLW) + (size_t)g * 128 * 128; t.K = 128; t.N = 128; t.mode = 0; t.item = r; return t; }
    };
    for (int it = gw; it < NITEMS; it += 2 * ngw) {
        const bool hasB = it + ngw < NITEMS;
        const TItem A = decode(it), B = decode(hasB ? it + ngw : it);
        float ra[32], rb[32];
        titem_load(A, ra, lane); titem_load(B, rb, lane);
        titem_finish(A, ra, scr, lane);
        if (hasB) titem_finish(B, rb, scr, lane);
    }
    { u32x4* z = (u32x4*)((bf16_t*)(ws + WS_WINE) + (size_t)2976 * D); const int n = 96 * D / 8; for (int i = gw * 64 + lane; i < n; i += ngw * 64) z[i] = (u32x4){0u, 0u, 0u, 0u};
      u32x4* z2 = (u32x4*)((bf16_t*)(ws + WS_WQUP) + (size_t)384 * 384); const int n2 = 128 * 384 / 8; for (int i = gw * 64 + lane; i < n2; i += ngw * 64) z2[i] = (u32x4){0u, 0u, 0u, 0u}; }
    const float* x = ap->in[0]; bf16_t* hb = (bf16_t*)(ws + WS_HB); float* ssq = (float*)(ws + WS_SSQ);
    for (int m0 = gw; m0 < M; m0 += 4 * ngw) {
        f32x4 v[4][8]; int mr[4]; bool ok[4];
#pragma unroll
        for (int q = 0; q < 4; ++q) { ok[q] = m0 + q * ngw < M; mr[q] = ok[q] ? m0 + q * ngw : m0; const GAS f32x4* xr = (const GAS f32x4*)((const GAS float*)x + (size_t)mr[q] * D) + lane;
#pragma unroll
            for (int j = 0; j < 8; ++j) v[q][j] = __builtin_nontemporal_load(xr + 64 * j); }
#pragma unroll
        for (int q = 0; q < 4; ++q) { GAS u32x2* o8 = (GAS u32x2*)((GAS bf16_t*)hb + (size_t)mr[q] * D) + lane; float sq = 0.f;
#pragma unroll
            for (int j = 0; j < 8; ++j) { const f32x4 w = v[q][j]; sq += (w.x * w.x + w.y * w.y) + (w.z * w.z + w.w * w.w);
                if (ok[q]) { u32x2 p; p.x = cvt_pk_bf16(w.x, w.y); p.y = cvt_pk_bf16(w.z, w.w); o8[64 * j] = p; } }
            sq = wave_sum(sq);
            if (ok[q] && lane < 32) ((GAS float*)ssq)[(size_t)mr[q] * 32 + lane] = lane == 0 ? sq : 0.f; } }
}

__device__ __forceinline__ void fast_grid_barrier(unsigned* bar, unsigned epoch, volatile LAS unsigned* bst) {
    __syncthreads();
    if (threadIdx.x == 0) {
        const unsigned xcc = bst[0], nx = bst[1], nxcd = bst[2];
        const unsigned old = __hip_atomic_fetch_add(bar + 64u * (1u + xcc), 1u, __ATOMIC_RELAXED, __HIP_MEMORY_SCOPE_AGENT);
        if (old + 1u == epoch * nx) { __builtin_amdgcn_fence(__ATOMIC_RELEASE, "agent"); __hip_atomic_fetch_add(bar, 1u, __ATOMIC_RELAXED, __HIP_MEMORY_SCOPE_AGENT); }
        while (__hip_atomic_load(bar, __ATOMIC_RELAXED, __HIP_MEMORY_SCOPE_AGENT) < epoch * nxcd) __builtin_amdgcn_s_sleep(1);
        __builtin_amdgcn_fence(__ATOMIC_ACQUIRE, "agent");
    }
    __syncthreads();
}

constexpr int LDS_BYTES = 147456;
constexpr int NSTEPS = 17 + (DUPSTEP >= 0 ? 1 : 0);

__global__ void __launch_bounds__(512, 2) mega(Args a) {
    extern __shared__ __attribute__((aligned(16))) unsigned char lds_raw[];
    LAS unsigned char* lds = (LAS unsigned char*)lds_raw;
    cg::grid_group grid = cg::this_grid();
    const int tid = threadIdx.x, lane0 = tid & 63, wave0 = __builtin_amdgcn_readfirstlane(tid >> 6);

    unsigned epoch = 0;
    volatile LAS unsigned* bst = (volatile LAS unsigned*)(lds + 139264);
    if (threadIdx.x == 0) { const unsigned xcc = (unsigned)__builtin_amdgcn_s_getreg((3 << 11) | 20) & 0xFu;
        bst[0] = xcc; __hip_atomic_fetch_add((unsigned*)(a.ws + WS_BAR) + 64u * (17u + xcc), 1u, __ATOMIC_RELAXED, __HIP_MEMORY_SCOPE_AGENT); }
    for (int step = a.lo; step < a.hi; ++step) {
        if (step > a.lo) {
            if (step == a.lo + 1) {
                grid.sync();
                if (threadIdx.x == 0) {
                    unsigned* bar = (unsigned*)(a.ws + WS_BAR); unsigned nxcd = 0;
                    for (unsigned x = 0; x < 16; ++x) nxcd += __hip_atomic_load(bar + 64u * (17u + x), __ATOMIC_RELAXED, __HIP_MEMORY_SCOPE_AGENT) != 0u;
                    bst[1] = __hip_atomic_load(bar + 64u * (17u + bst[0]), __ATOMIC_RELAXED, __HIP_MEMORY_SCOPE_AGENT); bst[2] = nxcd;
                }
            } else { ++epoch; fast_grid_barrier((unsigned*)(a.ws + WS_BAR), epoch, bst); }
        }
        int lane = lane0; asm volatile("" : "+v"(lane));
        ArgsP ap = (ArgsP)__builtin_amdgcn_kernarg_segment_ptr(); asm volatile("" : "+s"(ap));
        int wave = wave0, G = gridDim.x, bx = blockIdx.x; unsigned char* ws = ap->ws;
        asm volatile("" : "+s"(wave), "+s"(G), "+s"(bx), "+s"(ws));
        const int vcu = (G % 8 == 0) ? (bx % 8) * (G / 8) + bx / 8 : bx;
        const int gw = vcu * 8 + wave, ngw = G * 8;
        bf16_t* hb = (bf16_t*)(ws + WS_HB); bf16_t* act = (bf16_t*)(ws + WS_ACT); bf16_t* proj = (bf16_t*)(ws + WS_PROJ);
        bf16_t* qfb = (bf16_t*)(ws + WS_QF); bf16_t* kfb = (bf16_t*)(ws + WS_KF); bf16_t* vbb = (bf16_t*)(ws + WS_VB); bf16_t* mrg = (bf16_t*)(ws + WS_MRG);
        float* ssq = (float*)(ws + WS_SSQ); float* ste = (float*)(ws + WS_STE);
        const int* pos = (const int*)ap->in[1];
        float* hres = ap->out;
        const int kind = (DUPSTEP >= 0 && step > DUPSTEP) ? step - 1 : step;
        if (kind == 0 && PON(0)) { prologue(ap, ws, lds, gw, ngw, wave, lane); __syncthreads(); }
        else if (PON(1) && (kind == 1 || kind == 7 || kind == 9 || kind == 14)) {
            const int f = kind == 1 ? 0 : kind == 7 ? 1 : kind == 9 ? 2 : 3;
            pg8::Gemm g{hb, (const bf16_t*)(ws + WS_WGU) + (size_t)f * 3072 * D, M, 3072, D, D, D}; pg8::StaticOrder S; S.init(M, 3072, G, bx);
            EpiSwiglu E{ssq, act}; pg8::gemm_phase(lds, g, S, E);
        } else if (PON(2) && (kind == 2 || kind == 8 || kind == 10 || kind == 15 || kind == 6 || kind == 13)) {
            pg8::Gemm g; float coef;
            if (kind == 6) { g = pg8::Gemm{mrg, (const bf16_t*)(ws + WS_WOUTE), M, D, DME, DME, DME}; coef = 1.0f; }
            else if (kind == 13) { g = pg8::Gemm{mrg, (const bf16_t*)(ws + WS_WOUTO), M, D, DMO, DMO, DMO}; coef = 1.0f; }
            else { const int f = kind == 2 ? 0 : kind == 8 ? 1 : kind == 10 ? 2 : 3; g = pg8::Gemm{act, (const bf16_t*)(ws + WS_WD) + (size_t)f * D * FF, M, D, FF, FF, FF}; coef = 0.5f; }
            pg8::StaticOrder S; S.init(M, D, G, bx);
            EpiResid E{hb, ssq, coef}; pg8::gemm_phase(lds, g, S, E);
        } else if (PON(3) && kind == 3) {
            pg8::Gemm g{hb, (const bf16_t*)(ws + WS_WINE), M, INE, D, D, D}; pg8::StaticOrder S; S.init(M, INE, G, bx);
            EpiInEven E{ssq, pos, proj, ste, kfb}; pg8::gemm_phase(lds, g, S, E);
        } else if (PON(4) && kind == 4) {
#ifndef NO_QUP
            { pg8::Gemm g{proj + 2304, (const bf16_t*)(ws + WS_WQUP), M, 512, 384, INE, 384}; pg8::StaticOrder S; S.init(M, 512, G, bx);
              EpiQup E{ste, pos, qfb}; pg8::gemm_phase(lds, g, S, E); }
#endif
#ifndef NO_KVUP
            { pg8::Gemm g{proj + 2688, (const bf16_t*)(ws + WS_WKVUP), M, 768, 256, INE, 256}; pg8::StaticOrder S; S.init(M, 768, G, bx);
              EpiKvup E{ste, kfb, vbb}; pg8::gemm_phase(lds, g, S, E); }
#endif
        } else if (PON(5) && kind == 5) {
            {
            for (int pi = vcu; pi < 256; pi += G) { const int bh = pi >> 5, x = pi & 31, b = bh >> 2, hd = bh & 3; const size_t ro = (size_t)b * SEQ;
                for (int k = 0; k < 2; ++k) { const int qb = k == 0 ? 63 - x : x;
                    attn_unit<96, 1>(lds, qfb + ro * 384 + hd * 96, 384, kfb + ro * 384 + hd * 96, 384, vbb + ro * 512 + hd * 128, 512, mrg + ro * DME + 768 + hd * 128, DME, qb, 0); } }
            for (int ui = vcu; ui < 768; ui += G) { const int pb = ui & 15, r4 = (ui >> 4) & 3, hb6 = ui >> 6, hd = hb6 % 6, b = hb6 / 6; const size_t ro = (size_t)b * SEQ;
                attn_unit<128, 0>(lds, proj + ro * INE + hd * 128, INE, proj + ro * INE + 768 + hd * 128, INE, proj + ro * INE + 1536 + hd * 128, INE, mrg + ro * DME + hd * 128, DME, pb * 256, r4); }
            }
        } else if (PON(11) && kind == 11) {
            pg8::Gemm g{hb, (const bf16_t*)(ws + WS_WINO), M, INO, D, D, D}; pg8::StaticOrder S; S.init(M, INO, G, bx);
            EpiInOdd E{ssq, proj}; pg8::gemm_phase(lds, g, S, E);
        } else if (PON(12) && kind == 12) {
            {
            for (int pi = vcu; pi < 256; pi += G) { const int bh = pi >> 5, x = pi & 31, b = bh >> 2, hd = bh & 3; const size_t ro = (size_t)b * SEQ;
                for (int k = 0; k < 2; ++k) { const int qb = k == 0 ? 63 - x : x;
                    attn_unit<128, 2>(lds, proj + ro * INO + 512 + hd * 128, INO, proj + ro * INO + 1024 + hd * 128, INO, proj + ro * INO + 1536 + hd * 128, INO, mrg + ro * DMO + 512 + hd * 128, DMO, qb, 0); } }
            for (int wu = gw; wu < (M / 16) * 4; wu += ngw) pool_unit(proj, (const bf16_t*)(ws + WS_POOLW), ap->in[14], mrg, wu, lane);
            }
        } else if (PON(16) && kind == 16) {
            const float* gf = ap->in[16];
            const GAS f32x4* gr = (const GAS f32x4*)(const GAS float*)gf + lane;
            for (int m0 = gw; m0 < M; m0 += 8 * ngw) {
                u32x2 v[8][8]; float sq[8]; int mr[8]; bool ok[8];
#pragma unroll
                for (int q = 0; q < 8; ++q) { ok[q] = m0 + q * ngw < M; mr[q] = ok[q] ? m0 + q * ngw : m0;
                    sq[q] = lane < 32 ? ((const GAS float*)ssq)[(size_t)mr[q] * 32 + lane] : 0.f;
                    const GAS u32x2* br = (const GAS u32x2*)((const GAS bf16_t*)hb + (size_t)mr[q] * D) + lane;
#pragma unroll
                    for (int j = 0; j < 8; ++j) v[q][j] = br[64 * j]; }
#pragma unroll
                for (int q = 0; q < 8; ++q) { const float rq = 1.0f / sqrtf(wave_sum(sq[q]) * (1.0f / D) + EPS);
                    GAS f32x4* xr = (GAS f32x4*)((GAS float*)hres + (size_t)mr[q] * D) + lane;
#pragma unroll
                    for (int j = 0; j < 8; ++j) { const f32x4 gg = gr[64 * j]; const f32x4 a = (f32x4){bf_lo(v[q][j].x), bf_hi(v[q][j].x), bf_lo(v[q][j].y), bf_hi(v[q][j].y)};
                        if (ok[q]) __builtin_nontemporal_store(a * rq * gg, xr + 64 * j); } } }
        }
    }
}

extern "C" void kernel_launch(void* const* d_in, const int* in_sizes, int n_in, void* d_out, int out_size, void* d_ws, size_t ws_size, hipStream_t stream) {
    static int grid = 0;
    if (grid == 0) {
        if (n_in != 17 || out_size != M * D || ws_size < WS_END) { fprintf(stderr, "kernel_launch: unexpected shapes (n_in %d out %d ws %zu need %zu)\n", n_in, out_size, ws_size, (size_t)WS_END); grid = -1; return; }
        int dev = 0, cus = 0, per_cu = 0;
        hipGetDevice(&dev); hipDeviceGetAttribute(&cus, hipDeviceAttributeMultiprocessorCount, dev);
        if (hipFuncSetAttribute((const void*)mega, hipFuncAttributeMaxDynamicSharedMemorySize, LDS_BYTES) != hipSuccess) { fprintf(stderr, "kernel_launch: hipFuncSetAttribute failed\n"); grid = -1; return; }
        if (hipOccupancyMaxActiveBlocksPerMultiprocessor(&per_cu, (const void*)mega, 512, LDS_BYTES) != hipSuccess || per_cu < 1) { fprintf(stderr, "kernel_launch: occupancy query says %d blocks per CU\n", per_cu); per_cu = 1; }
        (void)hipGetLastError();
        grid = cus * per_cu;
        fprintf(stderr, "kernel_launch: grid %d (cus %d x %d)\n", grid, cus, per_cu);
    }
    if (grid < 0) return;
    Args a{};
    for (int i = 0; i < 17; ++i) a.in[i] = (const float*)d_in[i];
    a.out = (float*)d_out; a.ws = (unsigned char*)d_ws;
    if (hipMemsetAsync((unsigned char*)d_ws + WS_BAR, 0, 16384, stream) != hipSuccess) { fprintf(stderr, "kernel_launch: memset of the barrier word failed\n"); return; }
#if ONE_LAUNCH
    a.lo = 0; a.hi = NSTEPS;
    void* args[] = {&a};
    hipError_t e = hipLaunchCooperativeKernel((const void*)mega, dim3(grid), dim3(512), args, LDS_BYTES, stream);
    if (e != hipSuccess) fprintf(stderr, "kernel_launch: cooperative launch failed: %s (grid %d)\n", hipGetErrorString(e), grid);
#else
    for (int s = 0; s < NSTEPS; ++s) { a.lo = s; a.hi = s + 1; hipLaunchKernelGGL(mega, dim3(grid), dim3(512), LDS_BYTES, stream, a); }
#endif
}
```
